# Optimizing an MI355X kernel written in HIP

```python
import math
import jax
import jax.numpy as jnp
from jax import lax
import numpy as np

D_MODEL = 1024
BATCH = 4
SEQ = 4096
DEPTH = 2

HEAD_DIM = 64
ROPE_DIM = HEAD_DIM // 4
ROPE_THETA = 500000.0
NORM_EPS = 1e-6
Q_BLOCK = 128

A_HEADS = D_MODEL // 128
A_WIDTH = A_HEADS * HEAD_DIM
A_PATTERNS = ((128, 1), (512, 4), (2048, 16))

B_WIDTH = D_MODEL - A_WIDTH
B_GROUP = 16
B_GROUPS = B_WIDTH // B_GROUP
B_STATE = 64
DT_MIN = 1e-3
DT_MAX = 1e-1

C_HEADS = D_MODEL // HEAD_DIM
C_NOPE = HEAD_DIM - ROPE_DIM
C_VDIM = HEAD_DIM
C_LATENT = D_MODEL // 4
IDX_HEADS = 8
IDX_DIM = 64
TOPK_MAX = 256
C_SPLITS = (C_HEADS * ROPE_DIM, C_HEADS * C_NOPE, C_LATENT, ROPE_DIM, IDX_HEADS * IDX_DIM, IDX_DIM)
C_IN = sum(C_SPLITS) + IDX_HEADS

FF_DENSE = ((8 * D_MODEL // 3 + 127) // 128) * 128
N_EXPERTS = 8
TOP_K_EXPERTS = 2
FF_EXPERT = 7 * D_MODEL // 2

kernel_name = 'hybrid_dilated_s5_dsa_moe_adaln'


def rms_norm(x, g):
    xf = x.astype(jnp.float32)
    y = xf * lax.rsqrt(jnp.mean(xf * xf, axis=-1, keepdims=True) + NORM_EPS)
    return (y * g.astype(jnp.float32)).astype(x.dtype)


def modulate(x, shift, scale):
    return x * (1 + scale[:, None, :]) + shift[:, None, :]


def rope_tables(seq):
    pos = jnp.arange(seq, dtype=jnp.float32)
    inv = ROPE_THETA ** (-jnp.arange(0, ROPE_DIM, 2, dtype=jnp.float32) / ROPE_DIM)
    ang = pos[:, None] * inv[None, :]
    return jnp.cos(ang), jnp.sin(ang)


def apply_rope(x, cos, sin):
    half = ROPE_DIM // 2
    xf = x.astype(jnp.float32)
    x1, x2, rest = xf[..., :half], xf[..., half:ROPE_DIM], xf[..., ROPE_DIM:]
    cs, sn = cos[:, None, :], sin[:, None, :]
    out = jnp.concatenate([x1 * cs - x2 * sn, x2 * cs + x1 * sn, rest], axis=-1)
    return out.astype(x.dtype)


def to_blocks(a):
    bn, s = a.shape[:2]
    return jnp.moveaxis(a.reshape((bn, s // Q_BLOCK, Q_BLOCK) + a.shape[2:]), 1, 0)


def from_blocks(a):
    a = jnp.moveaxis(a, 0, 1)
    return a.reshape((a.shape[0], a.shape[1] * a.shape[2]) + a.shape[3:])


def gather_rows(a, idx):
    return jax.vmap(lambda ab, ib: ab[ib])(a, idx)


def swiglu(u, w_gate, w_up, w_down):
    return (jax.nn.silu(u @ w_gate) * (u @ w_up)) @ w_down


def dilated_attention(q, k, v):
    bn, s, h, dh = q.shape
    f32 = jnp.float32
    scale = dh ** -0.5

    def block(args):
        blk, qb = args
        t = blk * Q_BLOCK + jnp.arange(Q_BLOCK)
        qf = qb.astype(f32) * scale
        ms, ls, os_ = [], [], []
        for window, dil in A_PATTERNS:
            n_keys = window // dil + 1
            src = t[:, None] - dil * jnp.arange(n_keys)[None, :]
            valid = src >= 0
            src = jnp.maximum(src, 0)
            kg = jnp.take(k, src, axis=1).astype(f32)
            vg = jnp.take(v, src, axis=1).astype(f32)
            sc = jnp.einsum('bqhd,bqnhd->bhqn', qf, kg)
            sc = jnp.where(valid[None, None], sc, -jnp.inf)
            m = jnp.max(sc, axis=-1)
            p = jnp.exp(sc - m[..., None])
            ms.append(m)
            ls.append(jnp.sum(p, axis=-1))
            os_.append(jnp.einsum('bhqn,bqnhd->bhqd', p, vg))
        m_st = jnp.stack(ms)
        wts = jnp.exp(m_st - jnp.max(m_st, axis=0, keepdims=True))
        den = jnp.sum(wts * jnp.stack(ls), axis=0)
        num = jnp.einsum('gbhq,gbhqd->bhqd', wts, jnp.stack(os_))
        out = num / den[..., None]
        return jnp.swapaxes(out, 1, 2).astype(q.dtype)

    out = lax.map(block, (jnp.arange(s // Q_BLOCK), to_blocks(q)))
    return from_blocks(out)


def _complex_affine_combine(e1, e2):
    a1r, a1i, b1r, b1i = e1
    a2r, a2i, b2r, b2i = e2
    ar = a2r * a1r - a2i * a1i
    ai = a2r * a1i + a2i * a1r
    br = a2r * b1r - a2i * b1i + b2r
    bi = a2r * b1i + a2i * b1r + b2i
    return ar, ai, br, bi


def s5_mixer(u, a_re, a_im, log_dt, b_re, b_im, c_re, c_im, d_skip, w_glu, b_glu):
    bn, s, _ = u.shape
    f32 = jnp.float32
    ug = u.reshape(bn, s, B_GROUPS, B_GROUP).astype(f32)
    dt = jnp.exp(log_dt.astype(f32))[:, None]
    lr, li = a_re.astype(f32), a_im.astype(f32)
    mag = jnp.exp(lr * dt)
    abar_r = mag * jnp.cos(li * dt)
    abar_i = mag * jnp.sin(li * dt)
    den = lr * lr + li * li
    nr = abar_r - 1.0
    fr = (nr * lr + abar_i * li) / den
    fi = (abar_i * lr - nr * li) / den
    br, bi = b_re.astype(f32), b_im.astype(f32)
    bbar_r = fr[..., None] * br - fi[..., None] * bi
    bbar_i = fr[..., None] * bi + fi[..., None] * br
    bu_r = jnp.einsum('bsgc,gpc->bsgp', ug, bbar_r)
    bu_i = jnp.einsum('bsgc,gpc->bsgp', ug, bbar_i)
    full = bu_r.shape
    _, _, xr, xi = lax.associative_scan(
        _complex_affine_combine,
        (jnp.broadcast_to(abar_r, full), jnp.broadcast_to(abar_i, full), bu_r, bu_i),
        axis=1)
    y = (jnp.einsum('bsgp,gcp->bsgc', xr, c_re.astype(f32))
         - jnp.einsum('bsgp,gcp->bsgc', xi, c_im.astype(f32))
         + d_skip.astype(f32) * ug)
    y = jax.nn.gelu(y.reshape(bn, s, B_WIDTH)).astype(u.dtype)
    return y * jax.nn.sigmoid(y @ w_glu + b_glu)


def even_mixer(u, cos, sin, w_in, w_out, a_re, a_im, log_dt, b_re, b_im, c_re, c_im,
               d_skip, w_glu, b_glu):
    bn, s, _ = u.shape
    proj = u @ w_in
    q, k, v, s_in = jnp.split(proj, [A_WIDTH, 2 * A_WIDTH, 3 * A_WIDTH], axis=-1)
    shp = (bn, s, A_HEADS, HEAD_DIM)
    q = apply_rope(q.reshape(shp), cos, sin)
    k = apply_rope(k.reshape(shp), cos, sin)
    v = v.reshape(shp)
    y_a = dilated_attention(q, k, v).reshape(bn, s, A_WIDTH)
    y_b = s5_mixer(s_in, a_re, a_im, log_dt, b_re, b_im, c_re, c_im, d_skip, w_glu, b_glu)
    return jnp.concatenate([y_a, y_b], axis=-1) @ w_out


def dsa_mixer(u, cos, sin, w_in, w_out, g_kv, w_uk, w_uv):
    bn, s, _ = u.shape
    f32 = jnp.float32
    topk = min(TOPK_MAX, s // 4)
    proj = u @ w_in
    cuts = [int(v) for v in np.cumsum(C_SPLITS)]
    q_r, q_n, ckv, k_r, q_i, k_i, w_i = jnp.split(proj, cuts, axis=-1)
    q_r = apply_rope(q_r.reshape(bn, s, C_HEADS, ROPE_DIM), cos, sin)
    q_n = q_n.reshape(bn, s, C_HEADS, C_NOPE)
    ckv = rms_norm(ckv, g_kv)
    k_r = apply_rope(k_r.reshape(bn, s, 1, ROPE_DIM), cos, sin)[:, :, 0]
    q_i = apply_rope(q_i.reshape(bn, s, IDX_HEADS, IDX_DIM), cos, sin)
    k_i = apply_rope(k_i.reshape(bn, s, 1, IDX_DIM), cos, sin)[:, :, 0]
    w_i = w_i * IDX_HEADS ** -0.5
    key_pos = jnp.arange(s)

    def block(args):
        blk, qr_b, qn_b, qi_b, wi_b = args
        t = blk * Q_BLOCK + jnp.arange(Q_BLOCK)
        logits = jnp.einsum('bqhd,bsd->bqhs', qi_b.astype(f32), k_i.astype(f32)) * IDX_DIM ** -0.5
        score = jnp.einsum('bqh,bqhs->bqs', wi_b.astype(f32), jax.nn.relu(logits))
        causal = key_pos[None, :] <= t[:, None]
        score = jnp.where(causal[None], score, -jnp.inf)
        _, idx = lax.top_k(score, topk)
        valid = idx <= t[None, :, None]
        ckv_g = gather_rows(ckv, idx).astype(f32)
        kr_g = gather_rows(k_r, idx).astype(f32)
        q_lat = jnp.einsum('bqhn,chn->bqhc', qn_b.astype(f32), w_uk.astype(f32))
        sc = (jnp.einsum('bqhc,bqkc->bhqk', q_lat, ckv_g)
              + jnp.einsum('bqhr,bqkr->bhqk', qr_b.astype(f32), kr_g)) * HEAD_DIM ** -0.5
        sc = jnp.where(valid[:, None], sc, -jnp.inf)
        p = jax.nn.softmax(sc, axis=-1)
        o_lat = jnp.einsum('bhqk,bqkc->bqhc', p, ckv_g)
        return jnp.einsum('bqhc,chd->bqhd', o_lat, w_uv.astype(f32)).astype(u.dtype)

    out = lax.map(block, (jnp.arange(s // Q_BLOCK), to_blocks(q_r), to_blocks(q_n),
                          to_blocks(q_i), to_blocks(w_i)))
    out = from_blocks(out).reshape(bn, s, C_HEADS * C_VDIM)
    return out @ w_out


def moe_swiglu(u, w_router, b_router, w_gate, w_up, w_down):
    bn, s, d = u.shape
    f32 = jnp.float32
    tok = u.reshape(bn * s, d)
    logits = tok.astype(f32) @ w_router.astype(f32) + b_router.astype(f32)
    top_val, top_idx = lax.top_k(logits, TOP_K_EXPERTS)
    gates = jax.nn.softmax(top_val, axis=-1)
    combine = jnp.einsum('tk,tke->te', gates, jax.nn.one_hot(top_idx, N_EXPERTS, dtype=f32))
    out = jnp.zeros((bn * s, d), f32)
    for e in range(N_EXPERTS):
        out = out + combine[:, e:e + 1] * swiglu(tok, w_gate[e], w_up[e], w_down[e]).astype(f32)
    return out.astype(u.dtype).reshape(bn, s, d)


def setup_inputs(seed: int = 0) -> dict:
    key = jax.random.key(seed)
    keys = iter(jax.random.split(key, 48))
    f32 = jnp.float32

    def nrm(shape, scale):
        return jax.random.normal(next(keys), shape, f32) * scale

    def gain(shape):
        return 1.0 + nrm(shape, 0.05)

    ne, no = (DEPTH + 1) // 2, DEPTH // 2
    d = D_MODEL
    n_idx = jnp.arange(B_STATE, dtype=f32)
    log_dt = math.log(DT_MIN) + jax.random.uniform(next(keys), (ne, B_GROUPS), f32) * (
        math.log(DT_MAX) - math.log(DT_MIN))
    return {
        'x': nrm((BATCH, SEQ, d), 1.0),
        'c': nrm((BATCH, d), 1.0),
        'w_ada': nrm((DEPTH, d, 6 * d), 0.5 * d ** -0.5),
        'b_ada': nrm((DEPTH, 6 * d), 0.02),
        'g_mix': gain((DEPTH, d)),
        'g_ffn': gain((DEPTH, d)),
        'g_final': gain((d,)),
        'e_w_in': nrm((ne, d, 3 * A_WIDTH + B_WIDTH), d ** -0.5),
        'e_w_out': nrm((ne, A_WIDTH + B_WIDTH, d), (A_WIDTH + B_WIDTH) ** -0.5),
        's5_a_re': -0.5 * jnp.exp(nrm((ne, B_GROUPS, B_STATE), 0.05)),
        's5_a_im': math.pi * n_idx + nrm((ne, B_GROUPS, B_STATE), 0.01),
        's5_log_dt': log_dt,
        's5_b_re': nrm((ne, B_GROUPS, B_STATE, B_GROUP), (2 * B_GROUP) ** -0.5),
        's5_b_im': nrm((ne, B_GROUPS, B_STATE, B_GROUP), (2 * B_GROUP) ** -0.5),
        's5_c_re': nrm((ne, B_GROUPS, B_GROUP, B_STATE), (2 * B_STATE) ** -0.5),
        's5_c_im': nrm((ne, B_GROUPS, B_GROUP, B_STATE), (2 * B_STATE) ** -0.5),
        's5_d': nrm((ne, B_GROUPS, B_GROUP), 1.0),
        's5_w_glu': nrm((ne, B_WIDTH, B_WIDTH), B_WIDTH ** -0.5),
        's5_b_glu': nrm((ne, B_WIDTH), 0.02),
        'ff_w_gate': nrm((ne, d, FF_DENSE), d ** -0.5),
        'ff_w_up': nrm((ne, d, FF_DENSE), d ** -0.5),
        'ff_w_down': nrm((ne, FF_DENSE, d), FF_DENSE ** -0.5),
        'o_w_in': nrm((no, d, C_IN), d ** -0.5),
        'o_w_out': nrm((no, C_HEADS * C_VDIM, d), (C_HEADS * C_VDIM) ** -0.5),
        'mla_g_kv': gain((no, C_LATENT)),
        'mla_w_uk': nrm((no, C_LATENT, C_HEADS, C_NOPE), C_LATENT ** -0.5),
        'mla_w_uv': nrm((no, C_LATENT, C_HEADS, C_VDIM), C_LATENT ** -0.5),
        'moe_w_router': nrm((no, d, N_EXPERTS), d ** -0.5),
        'moe_b_router': nrm((no, N_EXPERTS), 0.01),
        'moe_w_gate': nrm((no, N_EXPERTS, d, FF_EXPERT), d ** -0.5),
        'moe_w_up': nrm((no, N_EXPERTS, d, FF_EXPERT), d ** -0.5),
        'moe_w_down': nrm((no, N_EXPERTS, FF_EXPERT, d), FF_EXPERT ** -0.5),
    }


def reference(x, c, w_ada, b_ada, g_mix, g_ffn, g_final,
              e_w_in, e_w_out, s5_a_re, s5_a_im, s5_log_dt, s5_b_re, s5_b_im,
              s5_c_re, s5_c_im, s5_d, s5_w_glu, s5_b_glu,
              ff_w_gate, ff_w_up, ff_w_down,
              o_w_in, o_w_out, mla_g_kv, mla_w_uk, mla_w_uv,
              moe_w_router, moe_b_router, moe_w_gate, moe_w_up, moe_w_down):
    s = x.shape[1]
    cos, sin = rope_tables(s)
    c_act = jax.nn.silu(c.astype(jnp.float32))
    h = x
    for layer in range(DEPTH):
        mod = (c_act @ w_ada[layer].astype(jnp.float32)
               + b_ada[layer].astype(jnp.float32)).astype(x.dtype)
        sh_m, sc_m, gt_m, sh_f, sc_f, gt_f = jnp.split(mod, 6, axis=-1)
        i = layer // 2
        u = modulate(rms_norm(h, g_mix[layer]), sh_m, sc_m)
        if layer % 2 == 0:
            y = even_mixer(u, cos, sin, e_w_in[i], e_w_out[i], s5_a_re[i], s5_a_im[i],
                           s5_log_dt[i], s5_b_re[i], s5_b_im[i], s5_c_re[i], s5_c_im[i],
                           s5_d[i], s5_w_glu[i], s5_b_glu[i])
        else:
            y = dsa_mixer(u, cos, sin, o_w_in[i], o_w_out[i], mla_g_kv[i], mla_w_uk[i], mla_w_uv[i])
        h = h + gt_m[:, None, :] * y
        u = modulate(rms_norm(h, g_ffn[layer]), sh_f, sc_f)
        if layer % 2 == 0:
            y = swiglu(u, ff_w_gate[i], ff_w_up[i], ff_w_down[i])
        else:
            y = moe_swiglu(u, moe_w_router[i], moe_b_router[i], moe_w_gate[i], moe_w_up[i], moe_w_down[i])
        h = h + gt_f[:, None, :] * y
    return rms_norm(h, g_final)
```

```cpp
#include <hip/hip_runtime.h>
#include <cstdio>
#include <cstdint>

#define LAS __attribute__((address_space(3)))
#define GAS __attribute__((address_space(1)))
typedef unsigned short bf16;
typedef short bf16x8 __attribute__((ext_vector_type(8)));
typedef short s16x4 __attribute__((ext_vector_type(4)));
typedef float f32x4 __attribute__((ext_vector_type(4)));
typedef float f32x2 __attribute__((ext_vector_type(2)));
typedef float f32x16 __attribute__((ext_vector_type(16)));
typedef unsigned u32x4 __attribute__((ext_vector_type(4)));
typedef unsigned u32x2 __attribute__((ext_vector_type(2)));

typedef __bf16 bf16x2_t __attribute__((ext_vector_type(2)));
__device__ __forceinline__ unsigned cvt_pk_bf16(float lo, float hi) { const f32x2 v = {lo, hi}; const bf16x2_t r = __builtin_convertvector(v, bf16x2_t); return __builtin_bit_cast(unsigned, r); }
__device__ __forceinline__ float sat448(float x) { return __builtin_amdgcn_fmed3f(x, -448.0f, 448.0f); }
__device__ __forceinline__ unsigned cvt_pk4_fp8(float a, float b, float c, float d) { int p = __builtin_amdgcn_cvt_pk_fp8_f32(sat448(a), sat448(b), 0, false); p = __builtin_amdgcn_cvt_pk_fp8_f32(sat448(c), sat448(d), p, true); return (unsigned)p; }
__device__ __forceinline__ float bf_lo(unsigned u) { return __builtin_bit_cast(float, u << 16); }
__device__ __forceinline__ float bf_hi(unsigned u) { return __builtin_bit_cast(float, u & 0xffff0000u); }
__device__ __forceinline__ float bf2f(bf16 v) { return __builtin_bit_cast(float, (unsigned)v << 16); }
__device__ __forceinline__ bf16 f2bf(float f) { return (bf16)(cvt_pk_bf16(f, 0.f) & 0xffffu); }
__device__ __forceinline__ float fast_exp(float x) { return __builtin_amdgcn_exp2f(x * 1.44269504089f); }
__device__ __forceinline__ float fast_rcp(float x) { return __builtin_amdgcn_rcpf(x); }
__device__ __forceinline__ float sigmoidf_(float x) { return fast_rcp(1.f + fast_exp(-x)); }

#ifdef DBG_NOGATHER
#define PMA(x) ((x) & 63)
#else
#define PMA(x) (x)
#endif
namespace pg8 {
constexpr int BM = 256, BK = 64, HALF = 128, HTB = HALF * BK * 2, STAGE_BYTES = 8 * HTB, NXCD = 8, WGM = 8;
__host__ __device__ __forceinline__ int lds_byte(int r, int c) { const int st = (r >> 4) * 2 + (c >> 5), rr = r & 15, cc = c & 31, ob = rr * 64 + cc * 2; return st * 1024 + (ob ^ (((ob >> 9) & 1) << 5)); }
__host__ __device__ __forceinline__ void stage_rc(int b, int& R, int& C) { const int st = b / 1024, sb = b % 1024, swz = sb ^ (((sb >> 9) & 1) << 5); R = (st >> 1) * 16 + swz / 64; C = (st & 1) * 32 + (swz % 64) / 2; }
__host__ __device__ __forceinline__ int perm32(int rho) { const int n = rho >> 4, i = rho & 15; return 8 * (i >> 2) + 4 * n + (i & 3); }

struct Unit { int pm, pn, pb, kt0, nkt; };
struct Gemm { const bf16* A; const bf16* Bt; int K; };

struct StaticOrder {
    static constexpr bool GATHER = false;
    int nM, nN, nwg, G, c;
    int nktf;
    __device__ void init(int M, int N, int K, int G_, int c_) { nM = M / BM; nN = N / BM; nwg = nM * nN; G = G_; c = c_; nktf = K / BK; }
    __device__ bool next(int i, Unit& u) const {
        const long L = (long)i * G + c; if (L >= nwg) return false;
        int wgid = (int)L; { const int q = nwg / NXCD, r = nwg % NXCD, xcd = wgid % NXCD, off = wgid / NXCD; wgid = (xcd < r ? xcd * (q + 1) : r * (q + 1) + (xcd - r) * q) + off; }
        const int nig = WGM * nN, gid = wgid / nig, fm = gid * WGM, gsz = (nM - fm) < WGM ? (nM - fm) : WGM;
        u.pm = fm + ((wgid % nig) % gsz); u.pn = (wgid % nig) / gsz; u.pb = u.pn; u.kt0 = 0; u.nkt = nktf; return true;
    }
    __device__ __forceinline__ unsigned arow(const Unit&, int) const { return 0u; }
};

typedef int v8i __attribute__((ext_vector_type(8)));
template <class Epi, class Sched, bool FP8 = false>
__device__ __forceinline__ void gemm_phase(LAS unsigned char* lds, const Gemm g, const Sched& S, const Epi& E, int wave_id) {
    constexpr bool GA = Sched::GATHER;
    int tid_ = wave_id * 64 + (int)__builtin_amdgcn_mbcnt_hi(~0u, __builtin_amdgcn_mbcnt_lo(~0u, 0u)); asm volatile("" : "+v"(tid_));
    const int tid = tid_, wid = __builtin_amdgcn_readfirstlane(tid >> 6), lane = tid & 63, wr = wid >> 2, wc = wid & 3, fr = lane & 15, fq = lane >> 4;
    const int K = g.K;
    unsigned voffA[2], voffB[2]; int RA[2], CA[2];
#pragma unroll
    for (int i = 0; i < 2; ++i) { int R, C; stage_rc(tid * 16 + i * 8192, R, C); const int Rb = (R & ~31) + perm32(R & 31);
        RA[i] = R; CA[i] = C; voffA[i] = (unsigned)(R * K + C) * 2u; voffB[i] = (unsigned)(Rb * K + C) * 2u; }
    const size_t kstep = (size_t)(BK * 2);
    const size_t hstep = (size_t)HALF * K * 2;
    const size_t tstep = 2 * hstep;
    const unsigned ldsw = (unsigned)wid * 1024u;
    const int aoff = lds_byte(wr * 64 + fr, FP8 ? fq * 16 : fq * 8), boff = lds_byte(wc * 32 + fr, FP8 ? fq * 16 : fq * 8);
    const int scale1 = 0x7f7f7f7f;
    constexpr int KOFF = FP8 ? 16 : 1024;
    unsigned cv[2][2], nv[2][2];
#define PG8_SA(b, h) (((b) * 2 + (h)) * HTB)
#define PG8_SB(b, h) ((4 + (b) * 2 + (h)) * HTB)
#define PG8_STAGE(bufoff, gbase, voff) do { _Pragma("unroll") for (int _i = 0; _i < 2; ++_i) \
        __builtin_amdgcn_global_load_lds((const unsigned*)((const char*)(gbase) + (voff)[_i]), (LAS unsigned*)(lds + (bufoff) + ldsw + _i * 8192), 16, 0, 0); } while (0)
#define PG8_STAGE_A(bufoff, p, h, NX) do { if constexpr (GA) { unsigned _v[2]; _v[0] = (NX) ? nv[h][0] : cv[h][0]; _v[1] = (NX) ? nv[h][1] : cv[h][1]; PG8_STAGE(bufoff, p, _v); } \
        else { PG8_STAGE(bufoff, (p) + ((h) ? hstep : 0), voffA); } } while (0)
#define PG8_LD8(p) ({ const u32x4 _lo = *(const LAS u32x4*)(p), _hi = *(const LAS u32x4*)((p) + KOFF); (v8i){(int)_lo.x, (int)_lo.y, (int)_lo.z, (int)_lo.w, (int)_hi.x, (int)_hi.y, (int)_hi.z, (int)_hi.w}; })
#define PG8_LDA(dst, b, h) do { _Pragma("unroll") for (int m = 0; m < 4; ++m) dst[m] = PG8_LD8(lds + PG8_SA(b, h) + aoff + m * 2048); } while (0)
#define PG8_LDB(dst, b, h) do { _Pragma("unroll") for (int n = 0; n < 2; ++n) dst[n] = PG8_LD8(lds + PG8_SB(b, h) + boff + n * 2048); } while (0)
#define PG8_HALF(X, k) __builtin_bit_cast(bf16x8, (k) ? __builtin_shufflevector(X, X, 4, 5, 6, 7) : __builtin_shufflevector(X, X, 0, 1, 2, 3))
#define PG8_MMA(ai, bj, At, Bt) do { __builtin_amdgcn_s_setprio(1); \
        if constexpr (FP8) { _Pragma("unroll") for (int m = 0; m < 4; ++m) _Pragma("unroll") for (int n = 0; n < 2; ++n) \
            asm volatile("v_mfma_scale_f32_16x16x128_f8f6f4 %0, %1, %2, %0, %3, %3 op_sel_hi:[0,0,0]" : "+v"(acc[ai][bj][m][n]) : "v"(Bt[n]), "v"(At[m]), "v"(scale1)); } \
        else { _Pragma("unroll") for (int m = 0; m < 4; ++m) _Pragma("unroll") for (int n = 0; n < 2; ++n) _Pragma("unroll") for (int k = 0; k < 2; ++k) \
            acc[ai][bj][m][n] = __builtin_amdgcn_mfma_f32_16x16x32_bf16(PG8_HALF(Bt[n], k), PG8_HALF(At[m], k), acc[ai][bj][m][n], 0, 0, 0); } \
        __builtin_amdgcn_s_setprio(0); } while (0)
#ifdef DBG_VM0
#define PG8_WAIT_V(n) do { if constexpr (GA) asm volatile("s_waitcnt vmcnt(0)" ::: "memory"); else asm volatile("s_waitcnt vmcnt(" #n ")" ::: "memory"); } while (0)
#else
#define PG8_WAIT_V(n) asm volatile("s_waitcnt vmcnt(" #n ")" ::: "memory")
#endif
#define PG8_WAIT_L(n) asm volatile("s_waitcnt lgkmcnt(" #n ")" ::: "memory")
#define PG8_BAR __builtin_amdgcn_s_barrier()
#define PG8_SCHED __builtin_amdgcn_sched_barrier(0)
#define PG8_GROWS(dst, u) do { if constexpr (GA) { _Pragma("unroll") for (int _h = 0; _h < 2; ++_h) _Pragma("unroll") for (int _i = 0; _i < 2; ++_i) \
        dst[_h][_i] = (S.arow(u, _h * HALF + RA[_i]) * (unsigned)K + (unsigned)CA[_i]) * 2u; } } while (0)
    Unit cur, nxt; int ui = 0;
    if (!S.next(0, cur)) return;
    f32x4 acc[2][2][4][2];
    v8i At[4], B0[2], B1[2];
    int nt = cur.nkt;
    const char* cA = (GA ? (const char*)g.A : (const char*)g.A + (size_t)PMA(cur.pm) * tstep) + (size_t)cur.kt0 * kstep; const char* cB = (const char*)g.Bt + (size_t)cur.pb * tstep + (size_t)cur.kt0 * kstep;
    PG8_GROWS(cv, cur);
#pragma unroll
    for (int _h = 0; _h < 2; ++_h) { nv[_h][0] = cv[_h][0]; nv[_h][1] = cv[_h][1]; }
    PG8_STAGE(PG8_SB(0, 0), cB, voffB); PG8_STAGE(PG8_SB(0, 1), cB + hstep, voffB); PG8_STAGE_A(PG8_SA(0, 0), cA, 0, false); PG8_STAGE_A(PG8_SA(0, 1), cA, 1, false);
    if (wr == 1) PG8_BAR;
    PG8_WAIT_V(2); PG8_BAR;
    PG8_STAGE(PG8_SB(1, 0), cB + kstep, voffB); PG8_STAGE_A(PG8_SA(1, 0), cA + kstep, 0, false); PG8_STAGE(PG8_SB(1, 1), cB + hstep + kstep, voffB);
    PG8_WAIT_V(6); PG8_BAR;
#pragma unroll
    for (int a = 0; a < 2; ++a)
#pragma unroll
        for (int b = 0; b < 2; ++b)
#pragma unroll
            for (int m = 0; m < 4; ++m)
#pragma unroll
                for (int n = 0; n < 2; ++n) acc[a][b][m][n] = (f32x4){0.f, 0.f, 0.f, 0.f};
    for (;;) {
        const bool has_next = S.next(ui + 1, nxt);
        const char* nA = has_next ? (GA ? (const char*)g.A : (const char*)g.A + (size_t)PMA(nxt.pm) * tstep) + (size_t)nxt.kt0 * kstep : cA; const char* nB = has_next ? (const char*)g.Bt + (size_t)nxt.pb * tstep + (size_t)nxt.kt0 * kstep : cB;
        if (has_next) { PG8_GROWS(nv, nxt); }
        for (int t = 0; t < nt; t += 2) {
            const bool last = (t == nt - 2);
            const char* a1 = cA + (size_t)(t + 1) * kstep;
            const char* a2 = last ? nA : cA + (size_t)(t + 2) * kstep; const char* b2 = last ? nB : cB + (size_t)(t + 2) * kstep;
            const char* a3 = a2 + kstep; const char* b3 = b2 + kstep;
            PG8_LDB(B0, 0, 0); PG8_LDB(B1, 0, 1); PG8_SCHED; PG8_LDA(At, 0, 0); PG8_STAGE_A(PG8_SA(1, 1), a1, 1, false);
            PG8_WAIT_V(8); PG8_WAIT_L(0); PG8_BAR; PG8_MMA(0, 0, At, B0); PG8_MMA(0, 1, At, B1); PG8_BAR; PG8_SCHED;
            PG8_LDA(At, 0, 1); PG8_STAGE(PG8_SB(0, 0), b2, voffB); PG8_STAGE(PG8_SB(0, 1), b2 + hstep, voffB); PG8_STAGE_A(PG8_SA(0, 0), a2, 0, last);
            PG8_WAIT_V(8); PG8_WAIT_L(0); PG8_BAR; PG8_MMA(1, 0, At, B0); PG8_MMA(1, 1, At, B1); PG8_BAR; PG8_SCHED;
            PG8_LDB(B0, 1, 0); PG8_LDB(B1, 1, 1); PG8_SCHED; PG8_LDA(At, 1, 0); PG8_STAGE_A(PG8_SA(0, 1), a2, 1, last);
            PG8_WAIT_V(8); PG8_WAIT_L(0); PG8_BAR; PG8_MMA(0, 0, At, B0); PG8_MMA(0, 1, At, B1); PG8_BAR; PG8_SCHED;
            PG8_LDA(At, 1, 1); PG8_STAGE(PG8_SB(1, 0), b3, voffB); PG8_STAGE(PG8_SB(1, 1), b3 + hstep, voffB); PG8_STAGE_A(PG8_SA(1, 0), a3, 0, last);
            PG8_WAIT_V(8); PG8_WAIT_L(0); PG8_BAR; PG8_MMA(1, 0, At, B0); PG8_MMA(1, 1, At, B1); PG8_BAR; PG8_SCHED;
        }
        if constexpr (FP8) asm volatile("s_nop 7\n\ts_nop 7\n\ts_nop 7\n\ts_nop 7\n\ts_nop 7\n\ts_nop 7\n\ts_nop 7\n\ts_nop 7" ::: "memory");
        if (wr == 0) PG8_BAR;
        E(acc, cur, wr, wc, fr, fq);
        if (!has_next) break;
#pragma unroll
        for (int a = 0; a < 2; ++a)
#pragma unroll
            for (int b = 0; b < 2; ++b)
#pragma unroll
                for (int m = 0; m < 4; ++m)
#pragma unroll
                    for (int n = 0; n < 2; ++n) acc[a][b][m][n] = (f32x4){0.f, 0.f, 0.f, 0.f};
        cur = nxt; cA = nA; cB = nB; ++ui; nt = cur.nkt;
#pragma unroll
        for (int _h = 0; _h < 2; ++_h) { cv[_h][0] = nv[_h][0]; cv[_h][1] = nv[_h][1]; }
        if (wr == 1) PG8_BAR;
    }
    PG8_WAIT_V(0);
    PG8_BAR;
#undef PG8_SA
#undef PG8_SB
#undef PG8_STAGE
#undef PG8_STAGE_A
#undef PG8_LDA
#undef PG8_LDB
#undef PG8_MMA
#undef PG8_HALF
#undef PG8_LD8
#undef PG8_WAIT_V
#undef PG8_WAIT_L
#undef PG8_BAR
#undef PG8_SCHED
#undef PG8_GROWS
}
}

constexpr int NB = 4, SEQ = 4096, T = NB * SEQ, D = 1024;
constexpr int FFD = 2816, FFE = 3584, NEXP = 8;
constexpr int CIN = 1880;
constexpr int NWAVES = 8, NTHR = 512;
constexpr float NORM_EPS = 1e-6f;

constexpr size_t MiB = 1u << 20;
constexpr size_t WS_CTL = 0, CTL_ZERO_BYTES = 1 * MiB;
constexpr size_t WS_MODP = 1 * MiB;
constexpr size_t WS_MODF = 4 * MiB;
constexpr size_t WS_ROPE = 4 * MiB + 256 * 1024;
constexpr size_t WS_ABAR = 4 * MiB + 512 * 1024;
constexpr size_t WS_BBAR = 4 * MiB + 576 * 1024;
constexpr size_t WS_CMAT = 5 * MiB;
constexpr size_t WS_XEND = 5 * MiB + 256 * 1024;
constexpr size_t WS_WUK  = 6 * MiB + 512 * 1024;
constexpr size_t WS_WUV  = 7 * MiB;
constexpr size_t WS_LIST = 7 * MiB + 512 * 1024;
constexpr size_t WS_LGATE = 8 * MiB;
constexpr size_t WS_KI   = 9 * MiB;
constexpr size_t WS_WI   = 11 * MiB;
constexpr size_t WS_WIN0 = 16 * MiB;
constexpr size_t WS_WOUT0 = 20 * MiB;
constexpr size_t WS_WGLU = 22 * MiB;
constexpr size_t WS_WGU0 = 23 * MiB;
constexpr size_t WS_WDN0 = 34 * MiB;
constexpr size_t WS_WIN1 = 40 * MiB;
constexpr size_t WS_WOUT1 = 44 * MiB;
constexpr size_t WS_WMGU = 46 * MiB;
constexpr size_t WS_WMDN = 102 * MiB;
constexpr size_t WS_H = 136 * MiB;
constexpr size_t WS_U = 216 * MiB;
constexpr size_t WS_PROJ = 248 * MiB;
constexpr size_t WS_CAT = 312 * MiB;
constexpr size_t WS_YG = 344 * MiB;
constexpr size_t WS_ACT0 = 248 * MiB;
constexpr size_t WS_QOP = 312 * MiB;
constexpr size_t WS_KOP = 448 * MiB;
constexpr size_t WS_QI = 457 * MiB;
constexpr size_t WS_IDX = 248 * MiB;
constexpr size_t WS_AOUT = 264 * MiB;
constexpr size_t WS_MACT = 248 * MiB;
constexpr size_t WS_U8 = 216 * MiB;
constexpr size_t WS_PART = 232 * MiB;
constexpr size_t WS_YSLOT = 16 * MiB;
constexpr size_t WS_END = 486 * MiB;
constexpr int MACT_ROWS = 34816;

constexpr int CW_CNT = 64;
constexpr int CW_BAR = 4096;

constexpr int RING_BYTES = 131072;
constexpr int MISC_OFF = 151552;
constexpr int LDS_BYTES = 152576;

#define RLX_AGENT __ATOMIC_RELAXED, __HIP_MEMORY_SCOPE_AGENT
#define LDS_WAIT() asm volatile("s_waitcnt lgkmcnt(0)" ::: "memory")
#define VM_WAIT() asm volatile("s_waitcnt vmcnt(0)" ::: "memory")
#define SBAR() __builtin_amdgcn_sched_barrier(0)

#define XB_TMO      128
#define XB_XCNT(j)  (256  + 64 * (j))
#define XB_XSUB(j)  (1280 + 64 * (j))
#define XB_XGEN(j)  (2304 + 64 * (j))
#define XB_TOP      3328
#define XB_TOPGEN   3392
#define XCD_BAR_WORDS 3456
#define XB_SPIN_CAP (1u << 22)

__device__ __forceinline__ unsigned xb_ld(unsigned* p)              { return __hip_atomic_load(p, __ATOMIC_RELAXED, __HIP_MEMORY_SCOPE_AGENT); }
__device__ __forceinline__ unsigned xb_add(unsigned* p, unsigned v) { return __hip_atomic_fetch_add(p, v, __ATOMIC_RELAXED, __HIP_MEMORY_SCOPE_AGENT); }
__device__ __forceinline__ unsigned xb_xcc_id() { return (unsigned)__builtin_amdgcn_s_getreg((3 << 11) | 20) & 0xFu; }
#define XB_SPIN(cond, bar) do { unsigned _sp = 0; while (cond) { __builtin_amdgcn_s_sleep(1); \
    if ((++_sp & 255u) == 0u) { if (xb_ld(&(bar)[XB_TMO])) break; if (_sp > XB_SPIN_CAP) { atomicAdd(&(bar)[XB_TMO], 1u); break; } } } } while (0)

struct XcdBarrier { unsigned* bar; unsigned x; volatile LAS unsigned* st; int wave; };
__device__ __forceinline__ int lane_id_() { return (int)__builtin_amdgcn_mbcnt_hi(~0u, __builtin_amdgcn_mbcnt_lo(~0u, 0u)); }

__device__ __forceinline__ XcdBarrier xcd_barrier_post(unsigned* bar, volatile LAS unsigned* st, int wave) {
    XcdBarrier b; b.bar = bar; b.x = xb_xcc_id(); b.st = st; b.wave = wave;
    if (wave == 0 && lane_id_() == 0) (void)xb_add(&bar[XB_XCNT(b.x)], 1u);
    return b;
}
__device__ __forceinline__ void xcd_barrier_complete(unsigned* bar, unsigned x, unsigned& nloc, unsigned& nx) {
    const unsigned G = gridDim.x * gridDim.y * gridDim.z;
    unsigned sum, cnt, mine, sp = 0u;
    for (;;) {
        sum = 0u; cnt = 0u; mine = 0u;
#pragma unroll
        for (unsigned j = 0; j < 16; ++j) { const unsigned c = xb_ld(&bar[XB_XCNT(j)]); sum += c; cnt += (c > 0u) ? 1u : 0u; mine = (j == x) ? c : mine; }
        if (sum == G) break;
        __builtin_amdgcn_s_sleep(1);
        if ((++sp & 255u) == 0u) { if (xb_ld(&bar[XB_TMO])) break; if (sp > XB_SPIN_CAP) { atomicAdd(&bar[XB_TMO], 1u); break; } }
    }
    nloc = mine > 0u ? mine : 1u; nx = cnt > 0u ? cnt : 1u;
}
__device__ __forceinline__ void xcd_barrier(const XcdBarrier& b) {
    asm volatile("s_waitcnt vmcnt(0)" ::: "memory");
    __syncthreads();
    if (b.wave == 0 && lane_id_() == 0) {
        unsigned* bar = b.bar;
        __builtin_amdgcn_s_waitcnt(0);
        unsigned nloc = b.st[0], nx = b.st[1];
        if (nloc == 0u) { xcd_barrier_complete(bar, b.x, nloc, nx); b.st[0] = nloc; b.st[1] = nx; }
        const unsigned old = xb_add(&bar[XB_XSUB(b.x)], 1u);
        const unsigned gen = old / nloc;
        if (old + 1u == (gen + 1u) * nloc) {
            __builtin_amdgcn_fence(__ATOMIC_RELEASE, "agent");
            asm volatile("s_waitcnt vmcnt(0)" ::: "memory");
            const unsigned og = xb_add(&bar[XB_TOP], 1u);
            const unsigned tg = og / nx;
            if (og + 1u == (tg + 1u) * nx) xb_add(&bar[XB_TOPGEN], 1u);
            else XB_SPIN(xb_ld(&bar[XB_TOPGEN]) == tg, bar);
            __builtin_amdgcn_fence(__ATOMIC_ACQUIRE, "agent");
            xb_add(&bar[XB_XGEN(b.x)], 1u);
            asm volatile("s_waitcnt vmcnt(0)" ::: "memory");
        } else {
            XB_SPIN(xb_ld(&bar[XB_XGEN(b.x)]) == gen, bar);
            __builtin_amdgcn_fence(__ATOMIC_ACQUIRE, "agent");
            asm volatile("s_waitcnt vmcnt(0)" ::: "memory");
        }
    }
    __syncthreads();
}

__device__ __forceinline__ float wave_sum(float v) {
#pragma unroll
    for (int o = 1; o < 64; o <<= 1) v += __shfl_xor(v, o);
    return v;
}

struct Args { const float* in[32]; float* out; unsigned char* ws; int ph_lo, ph_hi; };
enum { I_X = 0, I_C, I_WADA, I_BADA, I_GMIX, I_GFFN, I_GFINAL, I_EWIN, I_EWOUT, I_ARE, I_AIM, I_LOGDT, I_BRE, I_BIM, I_CRE, I_CIM, I_SD, I_WGLU, I_BGLU,
       I_FFG, I_FFU, I_FFD, I_OWIN, I_OWOUT, I_GKV, I_WUK, I_WUV, I_ROUTER, I_BROUTER, I_MG, I_MU, I_MD };

struct Ctx {
    LAS unsigned char* lds;
    int tid, lane, wave, G, vcu, gw, NGW;
    unsigned char* ws;
};

using pg8::Unit;

struct EpiProj {
    bf16* O; int ldc; const float* cs; int rope_tiles;
    __device__ __forceinline__ void operator()(const f32x4 (&acc)[2][2][4][2], const Unit& u, int wr, int wc, int fr, int fq) const {
        const int row0 = u.pm * 256 + wr * 64 + fr, col0 = u.pn * 256 + wc * 32 + fq * 8;
        const bool rope = (u.pn < rope_tiles) && ((wc & 1) == 0);
#pragma unroll
        for (int ai = 0; ai < 2; ++ai)
#pragma unroll
            for (int m = 0; m < 4; ++m) {
                const int row = row0 + ai * 128 + m * 16;
                f32x4 c0 = {1.f, 1.f, 1.f, 1.f}, c1 = c0, s0 = {0.f, 0.f, 0.f, 0.f}, s1 = s0;
                if (rope) { const f32x4* p = (const f32x4*)(cs + (size_t)(row & (SEQ - 1)) * 16); c0 = p[0]; c1 = p[1]; s0 = p[2]; s1 = p[3]; }
#pragma unroll
                for (int bj = 0; bj < 2; ++bj) {
                    f32x4 v0 = acc[ai][bj][m][0], v1 = acc[ai][bj][m][1];
                    if (rope) {
                        f32x4 o0, o1;
#pragma unroll
                        for (int e = 0; e < 4; ++e) { o0[e] = __shfl_xor(v0[e], 16); o1[e] = __shfl_xor(v1[e], 16); }
                        if (fq == 0) { v0 = v0 * c0 - o0 * s0; v1 = v1 * c1 - o1 * s1; }
                        else if (fq == 1) { v0 = v0 * c0 + o0 * s0; v1 = v1 * c1 + o1 * s1; }
                    }
                    u32x4 w; w.x = cvt_pk_bf16(v0[0], v0[1]); w.y = cvt_pk_bf16(v0[2], v0[3]); w.z = cvt_pk_bf16(v1[0], v1[1]); w.w = cvt_pk_bf16(v1[2], v1[3]);
                    *(u32x4*)(O + (size_t)row * ldc + col0 + bj * 128) = w;
                }
            }
    }
};

struct EpiGlu {
    bf16* O; int ldc, coff; const bf16* Y; int ldy; const float* bias;
    __device__ __forceinline__ void operator()(const f32x4 (&acc)[2][2][4][2], const Unit& u, int wr, int wc, int fr, int fq) const {
        const int row0 = u.pm * 256 + wr * 64 + fr, col0 = u.pn * 256 + wc * 32 + fq * 8;
#pragma unroll
        for (int bj = 0; bj < 2; ++bj) {
            const int col = col0 + bj * 128;
            const f32x4 b0 = *(const f32x4*)(bias + col), b1 = *(const f32x4*)(bias + col + 4);
#pragma unroll
            for (int ai = 0; ai < 2; ++ai)
#pragma unroll
                for (int m = 0; m < 4; ++m) {
                    const int row = row0 + ai * 128 + m * 16;
                    const u32x4 yv = *(const u32x4*)(Y + (size_t)row * ldy + col);
                    const f32x4 v0 = acc[ai][bj][m][0] + b0, v1 = acc[ai][bj][m][1] + b1;
                    float r[8];
                    r[0] = bf_lo(yv.x) * sigmoidf_(v0[0]); r[1] = bf_hi(yv.x) * sigmoidf_(v0[1]); r[2] = bf_lo(yv.y) * sigmoidf_(v0[2]); r[3] = bf_hi(yv.y) * sigmoidf_(v0[3]);
                    r[4] = bf_lo(yv.z) * sigmoidf_(v1[0]); r[5] = bf_hi(yv.z) * sigmoidf_(v1[1]); r[6] = bf_lo(yv.w) * sigmoidf_(v1[2]); r[7] = bf_hi(yv.w) * sigmoidf_(v1[3]);
                    u32x4 w; w.x = cvt_pk_bf16(r[0], r[1]); w.y = cvt_pk_bf16(r[2], r[3]); w.z = cvt_pk_bf16(r[4], r[5]); w.w = cvt_pk_bf16(r[6], r[7]);
                    *(u32x4*)(O + (size_t)row * ldc + coff + col) = w;
                }
        }
    }
};

__device__ __forceinline__ u32x4 pack8_bf16(const f32x4 a, const f32x4 b) { return (u32x4){cvt_pk_bf16(a[0], a[1]), cvt_pk_bf16(a[2], a[3]), cvt_pk_bf16(b[0], b[1]), cvt_pk_bf16(b[2], b[3])}; }
struct EpiResid {
    const float* base; bf16* out; const float* gate;
    __device__ __forceinline__ void operator()(const f32x4 (&acc)[2][2][4][2], const Unit& u, int wr, int wc, int fr, int fq) const {
        const int row0 = u.pm * 256 + wr * 64 + fr, col0 = u.pn * 256 + wc * 32 + fq * 8;
        const int b = (u.pm * 256) >> 12;
#pragma unroll
        for (int bj = 0; bj < 2; ++bj) {
            const int col = col0 + bj * 128;
            const f32x4 g0 = *(const f32x4*)(gate + b * 6144 + col), g1 = *(const f32x4*)(gate + b * 6144 + col + 4);
#pragma unroll
            for (int ai = 0; ai < 2; ++ai)
#pragma unroll
                for (int m = 0; m < 4; ++m) {
                    const size_t off = (size_t)(row0 + ai * 128 + m * 16) * D + col;
                    const f32x4 x0 = *(const f32x4*)(base + off), x1 = *(const f32x4*)(base + off + 4);
                    *(u32x4*)(out + off) = pack8_bf16(x0 + g0 * acc[ai][bj][m][0], x1 + g1 * acc[ai][bj][m][1]);
                }
        }
    }
};
struct EpiResidH {
    const bf16* base; bf16* out; const float* gate; float sc;
    __device__ __forceinline__ void operator()(const f32x4 (&acc)[2][2][4][2], const Unit& u, int wr, int wc, int fr, int fq) const {
        const int row0 = u.pm * 256 + wr * 64 + fr, col0 = u.pn * 256 + wc * 32 + fq * 8;
        const int b = (u.pm * 256) >> 12;
#pragma unroll
        for (int bj = 0; bj < 2; ++bj) {
            const int col = col0 + bj * 128;
            const f32x4 g0 = *(const f32x4*)(gate + b * 6144 + col) * sc, g1 = *(const f32x4*)(gate + b * 6144 + col + 4) * sc;
#pragma unroll
            for (int ai = 0; ai < 2; ++ai)
#pragma unroll
                for (int m = 0; m < 4; ++m) {
                    const size_t off = (size_t)(row0 + ai * 128 + m * 16) * D + col;
                    const u32x4 xv = *(const u32x4*)(base + off);
                    const f32x4 x0 = {bf_lo(xv.x), bf_hi(xv.x), bf_lo(xv.y), bf_hi(xv.y)}, x1 = {bf_lo(xv.z), bf_hi(xv.z), bf_lo(xv.w), bf_hi(xv.w)};
                    *(u32x4*)(out + off) = pack8_bf16(x0 + g0 * acc[ai][bj][m][0], x1 + g1 * acc[ai][bj][m][1]);
                }
        }
    }
};

struct EpiSwiglu {
    bf16* O; int ldc;
    __device__ __forceinline__ void operator()(const f32x4 (&acc)[2][2][4][2], const Unit& u, int wr, int wc, int fr, int fq) const {
        const int row0 = u.pm * 256 + wr * 64 + fr, col = u.pn * 128 + wc * 32 + fq * 8;
#pragma unroll
        for (int ai = 0; ai < 2; ++ai)
#pragma unroll
            for (int m = 0; m < 4; ++m) {
                const int row = row0 + ai * 128 + m * 16;
                float r[8];
#pragma unroll
                for (int n = 0; n < 2; ++n)
#pragma unroll
                    for (int e = 0; e < 4; ++e) { const float gt = acc[ai][0][m][n][e], up = acc[ai][1][m][n][e]; r[n * 4 + e] = gt * sigmoidf_(gt) * up; }
                u32x4 w; w.x = cvt_pk_bf16(r[0], r[1]); w.y = cvt_pk_bf16(r[2], r[3]); w.z = cvt_pk_bf16(r[4], r[5]); w.w = cvt_pk_bf16(r[6], r[7]);
                *(u32x4*)(O + (size_t)row * ldc + col) = w;
            }
    }
};

struct EpiSwigluS {
    bf16* O; int ldc;
    __device__ __forceinline__ void operator()(const f32x4 (&acc)[2][2][4][2], const Unit& u, int wr, int wc, int fr, int fq) const {
        const int row0 = u.pm * 256 + wr * 64 + fr, col = u.pn * 128 + wc * 32 + fq * 8;
#pragma unroll
        for (int ai = 0; ai < 2; ++ai)
#pragma unroll
            for (int m = 0; m < 4; ++m) {
                const int row = row0 + ai * 128 + m * 16;
                float r[8];
#pragma unroll
                for (int n = 0; n < 2; ++n)
#pragma unroll
                    for (int e = 0; e < 4; ++e) { const float gt = acc[ai][0][m][n][e] * 0.03125f, up = acc[ai][1][m][n][e] * 0.03125f; r[n * 4 + e] = gt * sigmoidf_(gt) * up; }
                u32x4 w; w.x = cvt_pk_bf16(r[0], r[1]); w.y = cvt_pk_bf16(r[2], r[3]); w.z = cvt_pk_bf16(r[4], r[5]); w.w = cvt_pk_bf16(r[6], r[7]);
                *(u32x4*)(O + (size_t)row * ldc + col) = w;
            }
    }
};

struct EpiSwiglu8 {
    unsigned char* O; int ldc;
    __device__ __forceinline__ void operator()(const f32x4 (&acc)[2][2][4][2], const Unit& u, int wr, int wc, int fr, int fq) const {
        const int row0 = u.pm * 256 + wr * 64 + fr, col = u.pn * 128 + wc * 32 + fq * 8;
#pragma unroll
        for (int ai = 0; ai < 2; ++ai)
#pragma unroll
            for (int m = 0; m < 4; ++m) {
                const int row = row0 + ai * 128 + m * 16;
                float r[8];
#pragma unroll
                for (int n = 0; n < 2; ++n)
#pragma unroll
                    for (int e = 0; e < 4; ++e) { const float gt = acc[ai][0][m][n][e] * 0.03125f, up = acc[ai][1][m][n][e] * 0.03125f; r[n * 4 + e] = gt * sigmoidf_(gt) * up; }
                *(u32x2*)(O + (size_t)row * ldc + col) = (u32x2){cvt_pk4_fp8(r[0], r[1], r[2], r[3]), cvt_pk4_fp8(r[4], r[5], r[6], r[7])};
            }
    }
};

template <bool GATHER_> struct MoeSched {
    static constexpr bool GATHER = GATHER_;
    const LAS int* tab; const int* list; int NT, G, c, nktf;
    __device__ __forceinline__ int expert_of_tile(int pm) const { int e = 0;
#pragma unroll
        for (int j = 1; j < 8; ++j) e += (pm >= tab[8 + j]) ? 1 : 0;
        return e; }
    __device__ bool next(int i, Unit& u) const {
        const int U = tab[16] * NT, xcd = c & 7, off = i * (G >> 3) + (c >> 3), q = U >> 3, r = U & 7;
        if ((G & 7) != 0) { const int L0 = i * G + c; if (L0 >= U) return false; return decode(L0, u); }
        if (off >= q + (xcd < r ? 1 : 0)) return false;
        return decode((xcd < r ? xcd * (q + 1) : r * (q + 1) + (xcd - r) * q) + off, u);
    }
    __device__ __forceinline__ bool decode(int L, Unit& u) const {
        int e = 0;
#pragma unroll
        for (int j = 1; j < 8; ++j) e += (L >= tab[8 + j] * NT) ? 1 : 0;
        const int l = L - tab[8 + e] * NT, Te = tab[9 + e] - tab[8 + e];
        const int nig = 8 * NT, gid = l / nig, fm = gid * 8, gsz = (Te - fm) < 8 ? (Te - fm) : 8, li = l - gid * nig;
        const int pn = li / gsz, pml = fm + (li - pn * gsz);
        u.pm = tab[8 + e] + pml; u.pn = pn; u.pb = e * NT + pn; u.kt0 = 0; u.nkt = nktf; return true;
    }
    __device__ __forceinline__ unsigned arow(const Unit& u, int r) const {
#ifdef DBG_ARITH
        return (unsigned)((u.pm * 256 + r) & 16383);
#endif
        const int e = expert_of_tile(u.pm); const int pos = (u.pm - tab[8 + e]) * 256 + r;
        return pos < tab[e] ? (unsigned)(list[e * 16384 + pos] & 0xffff) : 0u;
    }
};

struct MoeDownSched {
    static constexpr bool GATHER = false;
    const LAS int* tab; int G, c;
    __device__ bool next(int i, Unit& u) const {
        const int L = i * G + c;
        if (L < 512) { u.pn = L >> 7; u.pm = L & 127; u.kt0 = 0; u.nkt = 28; }
        else { const int Lt = L - 512, ntu = (tab[16] - 128) * 4; if (Lt >= ntu * 2) return false;
            const int tu = Lt >> 1; u.pm = 128 + (tu >> 2); u.pn = tu & 3; u.kt0 = (Lt & 1) * 14; u.nkt = 14; }
        int e = 0;
#pragma unroll
        for (int j = 1; j < 8; ++j) e += (u.pm >= tab[8 + j]) ? 1 : 0;
        u.pb = e * 4 + u.pn; return true;
    }
    __device__ __forceinline__ unsigned arow(const Unit&, int) const { return 0u; }
};
struct EpiMoeDown {
    bf16* Y; float* PART; const LAS int* tab; const int* list; const float* lgate;
    __device__ __forceinline__ void operator()(const f32x4 (&acc)[2][2][4][2], const Unit& u, int wr, int wc, int fr, int fq) const {
        int e = 0;
#pragma unroll
        for (int j = 1; j < 8; ++j) e += (u.pm >= tab[8 + j]) ? 1 : 0;
        const int pos0 = (u.pm - tab[8 + e]) * 256 + wr * 64 + fr, cnt = tab[e];
        const int col0 = u.pn * 256 + wc * 32 + fq * 8;
#pragma unroll
        for (int ai = 0; ai < 2; ++ai)
#pragma unroll
            for (int m = 0; m < 4; ++m) {
                const int pos = pos0 + ai * 128 + m * 16;
                if (pos < cnt) {
                    const int ts = list[e * 16384 + pos]; const float gw = lgate[e * 16384 + pos] * 0.03125f;
                    if (u.nkt == 28) {
                        bf16* dst = Y + ((size_t)(ts >> 16) * T + (size_t)(ts & 0xffff)) * D + col0;
#pragma unroll
                        for (int bj = 0; bj < 2; ++bj) { const f32x4 v0 = acc[ai][bj][m][0] * gw, v1 = acc[ai][bj][m][1] * gw;
                            *(u32x4*)(dst + bj * 128) = (u32x4){cvt_pk_bf16(v0[0], v0[1]), cvt_pk_bf16(v0[2], v0[3]), cvt_pk_bf16(v1[0], v1[1]), cvt_pk_bf16(v1[2], v1[3])}; }
                    } else {
                        float* dst = PART + ((size_t)(((u.pm - 128) * 4 + u.pn) * 2 + u.kt0 / 14) * 256 + (size_t)(wr * 64 + fr + ai * 128 + m * 16)) * 256 + wc * 32 + fq * 8;
#pragma unroll
                        for (int bj = 0; bj < 2; ++bj) { *(f32x4*)(dst + bj * 128) = acc[ai][bj][m][0] * gw; *(f32x4*)(dst + bj * 128 + 4) = acc[ai][bj][m][1] * gw; }
                    }
                }
            }
    }
};

__device__ __forceinline__ void transpose_item8(const float* W, int N, int kb, int nb, unsigned char* WT, int ldw, int row_base, LAS float* scr, int lane) {
    const int k0 = 64 * kb, n0 = 32 * nb;
#pragma unroll 8
    for (int i = 0; i < 32; ++i) { const int kk = 2 * i + (lane >> 5); scr[kk * 33 + (lane & 31)] = W[(size_t)(k0 + kk) * N + n0 + (lane & 31)]; }
    LDS_WAIT(); asm volatile("" ::: "memory");
    const int c = lane & 7;
#pragma unroll
    for (int j = 0; j < 4; ++j) { const int n = (lane >> 3) + 8 * j; const LAS float* s = scr + (8 * c) * 33 + n;
        u32x2 o; o.x = cvt_pk4_fp8(s[0 * 33] * 32.f, s[1 * 33] * 32.f, s[2 * 33] * 32.f, s[3 * 33] * 32.f); o.y = cvt_pk4_fp8(s[4 * 33] * 32.f, s[5 * 33] * 32.f, s[6 * 33] * 32.f, s[7 * 33] * 32.f);
        *(u32x2*)(WT + (size_t)(row_base + n) * ldw + k0 + 8 * c) = o; }
    LDS_WAIT(); asm volatile("" ::: "memory");
}
template <bool GUARD>
__device__ __forceinline__ void transpose_item(const float* W, int N, int kb, int nb, bf16* WT, int ldw, int row_base, LAS float* scr, int lane) {
    const int k0 = 64 * kb, n0 = 32 * nb;
#pragma unroll 8
    for (int i = 0; i < 32; ++i) { const int kk = 2 * i + (lane >> 5); const int n = n0 + (lane & 31);
        float v = 0.f; if (!GUARD || n < N) v = W[(size_t)(k0 + kk) * N + n];
        scr[kk * 33 + (lane & 31)] = v; }
    LDS_WAIT(); asm volatile("" ::: "memory");
    const int c = lane & 7;
#pragma unroll
    for (int j = 0; j < 4; ++j) { const int n = (lane >> 3) + 8 * j; const LAS float* s = scr + (8 * c) * 33 + n;
        u32x4 o; o.x = cvt_pk_bf16(s[0 * 33], s[1 * 33]); o.y = cvt_pk_bf16(s[2 * 33], s[3 * 33]); o.z = cvt_pk_bf16(s[4 * 33], s[5 * 33]); o.w = cvt_pk_bf16(s[6 * 33], s[7 * 33]);
        *(u32x4*)(WT + (size_t)(row_base + n) * ldw + k0 + 8 * c) = o; }
    LDS_WAIT(); asm volatile("" ::: "memory");
}
__device__ __forceinline__ int ilv_row(int n0, int up) { return (n0 >> 7) * 256 + (n0 & 127) + up * 128; }

__device__ __forceinline__ float rope_inv(int j) {
    return j == 0 ? 1.0f : j == 1 ? 0.1939227432012558f : j == 2 ? 0.03760603070259094f : j == 3 ? 0.007292664609849453f :
           j == 4 ? 0.0014142135623842478f : j == 5 ? 0.00027424818836152554f : j == 6 ? 5.3182957344688475e-05f : 1.0313385246263351e-05f;
}

__device__ __forceinline__ void p0_prologue(const Ctx& F, const Args& a) {
    unsigned char* ws = F.ws;
    LAS float* scr = (LAS float*)(F.lds + F.wave * 16384);
    constexpr int C1 = 16 * 64, C2 = 16 * 32, C3 = 8 * 16, C4 = 16 * 88, C6 = 44 * 32, C7 = 16 * 59, CM = 16 * 112, CD = 56 * 32;
    constexpr int NITEMS = C1 + C2 + C3 + 2 * C4 + C6 + C7 + C2 + 8 * (2 * CM + CD);
    for (int it = F.gw; it < NITEMS; it += F.NGW) {
        int r = it;
        if (r < C1) { transpose_item<false>(a.in[I_EWIN], 2048, r / 64, r % 64, (bf16*)(ws + WS_WIN0), 1024, 32 * (r % 64), scr, F.lane); continue; } r -= C1;
        if (r < C2) { transpose_item<false>(a.in[I_EWOUT], 1024, r / 32, r % 32, (bf16*)(ws + WS_WOUT0), 1024, 32 * (r % 32), scr, F.lane); continue; } r -= C2;
        if (r < C3) { transpose_item<false>(a.in[I_WGLU], 512, r / 16, r % 16, (bf16*)(ws + WS_WGLU), 512, 32 * (r % 16), scr, F.lane); continue; } r -= C3;
        if (r < C4) { transpose_item8(a.in[I_FFG], FFD, r / 88, r % 88, ws + WS_WGU0, 1024, ilv_row(32 * (r % 88), 0), scr, F.lane); continue; } r -= C4;
        if (r < C4) { transpose_item8(a.in[I_FFU], FFD, r / 88, r % 88, ws + WS_WGU0, 1024, ilv_row(32 * (r % 88), 1), scr, F.lane); continue; } r -= C4;
        if (r < C6) { transpose_item<false>(a.in[I_FFD], 1024, r / 32, r % 32, (bf16*)(ws + WS_WDN0), FFD, 32 * (r % 32), scr, F.lane); continue; } r -= C6;
        if (r < C7) { transpose_item<true>(a.in[I_OWIN], CIN, r / 59, r % 59, (bf16*)(ws + WS_WIN1), 1024, 32 * (r % 59), scr, F.lane); continue; } r -= C7;
        if (r < C2) { transpose_item<false>(a.in[I_OWOUT], 1024, r / 32, r % 32, (bf16*)(ws + WS_WOUT1), 1024, 32 * (r % 32), scr, F.lane); continue; } r -= C2;
        const int e = r / (2 * CM + CD); r -= e * (2 * CM + CD);
        if (r < CM) { transpose_item8(a.in[I_MG] + (size_t)e * 1024 * FFE, FFE, r / 112, r % 112, ws + WS_WMGU + (size_t)e * 7168 * 1024, 1024, ilv_row(32 * (r % 112), 0), scr, F.lane); continue; } r -= CM;
        if (r < CM) { transpose_item8(a.in[I_MU] + (size_t)e * 1024 * FFE, FFE, r / 112, r % 112, ws + WS_WMGU + (size_t)e * 7168 * 1024, 1024, ilv_row(32 * (r % 112), 1), scr, F.lane); continue; } r -= CM;
        transpose_item8(a.in[I_MD] + (size_t)e * FFE * 1024, 1024, r / 32, r % 32, ws + WS_WMDN + (size_t)e * 1024 * FFE, FFE, 32 * (r % 32), scr, F.lane);
    }
    const int gtid = F.vcu * NTHR + F.tid, NGT = F.G * NTHR;
    for (int i = gtid; i < 160 * 128; i += NGT) *(u32x4*)(ws + WS_WIN1 + (size_t)1888 * 2048 + (size_t)i * 16) = (u32x4){0u, 0u, 0u, 0u};
    for (int it = F.gw; it < 768; it += F.NGW) {
        const int layer = it / 384, r = it % 384, kc = r / 24, jc = r % 24;
        const int j = jc * 256 + F.lane * 4;
        float cv[4];
#pragma unroll
        for (int b = 0; b < 4; ++b) { const float x = a.in[I_C][b * 1024 + kc * 64 + F.lane]; cv[b] = x * sigmoidf_(x); }
        f32x4 acc[4] = {{0.f, 0.f, 0.f, 0.f}, {0.f, 0.f, 0.f, 0.f}, {0.f, 0.f, 0.f, 0.f}, {0.f, 0.f, 0.f, 0.f}};
        const float* wp = a.in[I_WADA] + ((size_t)layer * 1024 + kc * 64) * 6144 + j;
#pragma unroll 8
        for (int k = 0; k < 64; ++k) { const f32x4 w = *(const f32x4*)(wp + (size_t)k * 6144);
#pragma unroll
            for (int b = 0; b < 4; ++b) { const float s = __shfl(cv[b], k); acc[b] += w * s; } }
#pragma unroll
        for (int b = 0; b < 4; ++b) *(f32x4*)((float*)(ws + WS_MODP) + ((size_t)(kc * 2 + layer) * 4 + b) * 6144 + j) = acc[b];
    }
    for (int i = gtid; i < SEQ * 8; i += NGT) { const int pos = i >> 3, j = i & 7; const float ang = (float)pos * rope_inv(j);
        float* cs = (float*)(ws + WS_ROPE) + pos * 16; cs[j] = cosf(ang); cs[8 + j] = sinf(ang); }
    for (int i = gtid; i < 32 * 64; i += NGT) {
        const int g = i >> 6;
        const float dt = expf(a.in[I_LOGDT][g]), lr = a.in[I_ARE][i], li = a.in[I_AIM][i];
        const float mag = expf(lr * dt), ar = mag * cosf(li * dt), ai = mag * sinf(li * dt);
        const float den = lr * lr + li * li, nr = ar - 1.0f, fr = (nr * lr + ai * li) / den, fi = (ai * lr - nr * li) / den;
        float pr = ar, pi = ai;
#pragma unroll
        for (int s = 0; s < 8; ++s) { const float tr = pr * pr - pi * pi, ti = 2.f * pr * pi; pr = tr; pi = ti; }
        *(f32x4*)((float*)(ws + WS_ABAR) + i * 4) = (f32x4){ar, ai, pr, pi};
        bf16* bbr = (bf16*)(ws + WS_BBAR) + ((size_t)g * 128 + (i & 63)) * 16; bf16* bbi = bbr + 64 * 16;
#pragma unroll
        for (int c = 0; c < 16; ++c) { const float br = a.in[I_BRE][i * 16 + c], bi = a.in[I_BIM][i * 16 + c]; bbr[c] = f2bf(fr * br - fi * bi); bbi[c] = f2bf(fr * bi + fi * br); }
    }
    for (int i = gtid; i < 32 * 16 * 128; i += NGT) { const int gc = i >> 7, k = i & 127;
        const float v = (k < 64) ? a.in[I_CRE][gc * 64 + k] : -a.in[I_CIM][gc * 64 + (k - 64)];
        ((bf16*)(ws + WS_CMAT))[i] = f2bf(v); }
    for (int i = gtid; i < 16 * 256 * 64; i += NGT) { const int n = i & 63, c = (i >> 6) & 255, h = i >> 14;
        ((bf16*)(ws + WS_WUK))[i] = f2bf(n < 48 ? a.in[I_WUK][(c * 16 + h) * 48 + n] : 0.f); }
    for (int i = gtid; i < 16 * 64 * 256; i += NGT) { const int c = i & 255, d = (i >> 8) & 63, h = i >> 14;
        ((bf16*)(ws + WS_WUV))[i] = f2bf(a.in[I_WUV][(c * 16 + h) * 64 + d]); }
}

__device__ __forceinline__ f32x4 modp4(const Args& a, const unsigned char* ws, int layer, int b, int j) {
    f32x4 s = *(const f32x4*)(a.in[I_BADA] + layer * 6144 + j);
#pragma unroll
    for (int kc = 0; kc < 16; ++kc) s += *(const f32x4*)((const float*)(ws + WS_MODP) + ((size_t)(kc * 2 + layer) * 4 + b) * 6144 + j);
    return s;
}
template <bool FROMP, bool ROUTER, bool F8 = ROUTER, bool HB = true>
__device__ __forceinline__ void norm_phase(const Ctx& F, const Args& a, const void* h, const float* g, int layer, int sh_off, int sc_off) {
    unsigned char* ws = F.ws;
    const int row0 = F.gw * 8, b = row0 >> 12;
    f32x4 gs[4], sh[4];
#pragma unroll
    for (int j = 0; j < 4; ++j) { const int col = 4 * F.lane + 256 * j;
        f32x4 sc;
        if (FROMP) { sc = modp4(a, ws, layer, b, sc_off + col); sh[j] = modp4(a, ws, layer, b, sh_off + col); }
        else { const float* mf = (const float*)(ws + WS_MODF) + (size_t)(layer * 4 + b) * 6144; sc = *(const f32x4*)(mf + sc_off + col); sh[j] = *(const f32x4*)(mf + sh_off + col); }
        gs[j] = *(const f32x4*)(g + col) * (sc + 1.0f); }
    float wr[ROUTER ? 16 : 1][ROUTER ? 8 : 1]; float br[8];
    if (ROUTER) {
#pragma unroll
        for (int j = 0; j < 4; ++j)
#pragma unroll
            for (int e4 = 0; e4 < 4; ++e4) { const float* p = a.in[I_ROUTER] + (size_t)(4 * F.lane + 256 * j + e4) * 8; const f32x4 w0 = *(const f32x4*)p, w1 = *(const f32x4*)(p + 4);
#pragma unroll
                for (int e = 0; e < 4; ++e) { wr[j * 4 + e4][e] = w0[e]; wr[j * 4 + e4][4 + e] = w1[e]; } }
#pragma unroll
        for (int e = 0; e < 8; ++e) br[e] = a.in[I_BROUTER][e];
    }
    for (int r = 0; r < 8; ++r) {
        const int row = row0 + r;
        f32x4 v[4]; float s = 0.f;
#pragma unroll
        for (int j = 0; j < 4; ++j) {
            if (HB) { const u32x2 t = ((const u32x2*)((const bf16*)h + (size_t)row * D) + F.lane)[64 * j]; v[j] = (f32x4){bf_lo(t.x), bf_hi(t.x), bf_lo(t.y), bf_hi(t.y)}; }
            else v[j] = ((const f32x4*)((const float*)h + (size_t)row * D) + F.lane)[64 * j];
            s += (v[j].x * v[j].x + v[j].y * v[j].y) + (v[j].z * v[j].z + v[j].w * v[j].w); }
        const float rstd = 1.0f / sqrtf(wave_sum(s) * (1.f / D) + NORM_EPS);
        unsigned long long* o8 = (unsigned long long*)((bf16*)(ws + WS_U) + (size_t)row * D) + F.lane;
        unsigned* o4 = (unsigned*)(ws + WS_U8 + (size_t)row * D) + F.lane;
#pragma unroll
        for (int j = 0; j < 4; ++j) { v[j] = v[j] * rstd * gs[j] + sh[j];
            if (F8) o4[64 * j] = cvt_pk4_fp8(v[j].x, v[j].y, v[j].z, v[j].w);
            else o8[64 * j] = (unsigned long long)cvt_pk_bf16(v[j].x, v[j].y) | ((unsigned long long)cvt_pk_bf16(v[j].z, v[j].w) << 32); }
        if (ROUTER) {
            float lg[8];
#pragma unroll
            for (int e = 0; e < 8; ++e) { float t = 0.f;
#pragma unroll
                for (int j = 0; j < 4; ++j)
#pragma unroll
                    for (int e4 = 0; e4 < 4; ++e4) t += v[j][e4] * wr[j * 4 + e4][e];
                lg[e] = wave_sum(t) + br[e]; }
            if (F.lane == 0) {
                int e0 = 0; float v0 = lg[0];
#pragma unroll
                for (int e = 1; e < 8; ++e) if (lg[e] > v0) { v0 = lg[e]; e0 = e; }
                int e1 = -1; float v1 = -3.0e38f;
#pragma unroll
                for (int e = 0; e < 8; ++e) if (e != e0 && lg[e] > v1) { v1 = lg[e]; e1 = e; }
                const float g0 = 1.0f / (1.0f + expf(v1 - v0)), g1 = 1.0f - g0;
                unsigned* cnt = (unsigned*)(ws + WS_CTL) + CW_CNT;
                const unsigned p0 = __hip_atomic_fetch_add(cnt + e0, 1u, RLX_AGENT), p1 = __hip_atomic_fetch_add(cnt + e1, 1u, RLX_AGENT);
                ((int*)(ws + WS_LIST))[e0 * 16384 + p0] = row; ((float*)(ws + WS_LGATE))[e0 * 16384 + p0] = g0;
                ((int*)(ws + WS_LIST))[e1 * 16384 + p1] = row | (1 << 16); ((float*)(ws + WS_LGATE))[e1 * 16384 + p1] = g1;
                ((int*)(ws + WS_KI))[row * 2] = e0 * 16384 + (int)p0; ((int*)(ws + WS_KI))[row * 2 + 1] = e1 * 16384 + (int)p1;
            }
        }
    }
}
__device__ __forceinline__ void modf_finalize(const Ctx& F, const Args& a) {
    const int gtid = F.vcu * NTHR + F.tid, NGT = F.G * NTHR;
    for (int i = gtid; i < 2 * 4 * 1536; i += NGT) { const int j = (i % 1536) * 4, lb = i / 1536;
        *(f32x4*)((float*)(F.ws + WS_MODF) + (size_t)lb * 6144 + j) = modp4(a, F.ws, lb >> 2, lb & 3, j); }
}
__device__ __forceinline__ f32x4 moe_slot4(const unsigned char* ws, const LAS int* tab, int row, int slot, int j, int lane) {
    const int ep = ((const int*)(ws + WS_KI))[row * 2 + slot]; const int e = ep >> 14, pos = ep & 16383;
    const int srow = tab[8 + e] * 256 + pos, pm = srow >> 8;
    if (pm < 128) { const u32x2 v = *((const u32x2*)((const bf16*)(ws + WS_YSLOT) + ((size_t)slot * T + row) * D) + lane + 64 * j); return (f32x4){bf_lo(v.x), bf_hi(v.x), bf_lo(v.y), bf_hi(v.y)}; }
    const float* p = (const float*)(ws + WS_PART) + ((size_t)(((pm - 128) * 4 + j) * 2) * 256 + (srow & 255)) * 256 + 4 * lane;
    return *(const f32x4*)p + *(const f32x4*)(p + 65536);
}
__device__ __forceinline__ void final_phase(const Ctx& F, const Args& a) {
    const int row0 = F.gw * 8, b = row0 >> 12;
    const float* mf = (const float*)(F.ws + WS_MODF) + (size_t)(4 + b) * 6144 + 5120;
    const LAS int* tab = (const LAS int*)(F.lds + MISC_OFF + 64);
    f32x4 gt[4], gf[4];
#pragma unroll
    for (int j = 0; j < 4; ++j) { gt[j] = *(const f32x4*)(mf + 4 * F.lane + 256 * j); gf[j] = *(const f32x4*)(a.in[I_GFINAL] + 4 * F.lane + 256 * j); }
    for (int r = 0; r < 8; ++r) {
        const int row = row0 + r;
        f32x4* xr = (f32x4*)(a.out + (size_t)row * D) + F.lane;
        const u32x2* hr = (const u32x2*)((const bf16*)(F.ws + WS_H) + (size_t)row * D) + F.lane;
        f32x4 v[4]; float s = 0.f;
#ifndef DBG_NOMOE
#define DBG_NOMOE 1.0f
#endif
#pragma unroll
        for (int j = 0; j < 4; ++j) { const u32x2 t = hr[64 * j]; v[j] = (f32x4){bf_lo(t.x), bf_hi(t.x), bf_lo(t.y), bf_hi(t.y)} + gt[j] * ((moe_slot4(F.ws, tab, row, 0, j, F.lane) + moe_slot4(F.ws, tab, row, 1, j, F.lane)) * DBG_NOMOE); s += (v[j].x * v[j].x + v[j].y * v[j].y) + (v[j].z * v[j].z + v[j].w * v[j].w); }
        const float rstd = 1.0f / sqrtf(wave_sum(s) * (1.f / D) + NORM_EPS);
#pragma unroll
        for (int j = 0; j < 4; ++j) xr[64 * j] = v[j] * rstd * gf[j];
    }
}

__device__ __forceinline__ bf16x8 ld_bf16x8(const bf16* p) { return *(const bf16x8*)p; }
#define TRRD(dst, addr, off) asm volatile("ds_read_b64_tr_b16 %0, %1 offset:%c2" : "=&v"(dst) : "v"(addr), "i"(off) : "memory")

constexpr int S5_LDS = 14336;
template <bool PASS2>
__device__ __forceinline__ void s5_unit(const Ctx& F, const Args& a, int b, int g, int sc, LAS unsigned char* wl) {
    const unsigned char* ws = F.ws;
    const int lane = F.lane, fr = lane & 15, g4 = lane >> 4;
    const f32x4 ab = *(const f32x4*)((const float*)(ws + WS_ABAR) + (g * 64 + lane) * 4);
    const float ar = ab.x, ai = ab.y;
    bf16x8 bt[8];
#pragma unroll
    for (int nt = 0; nt < 8; ++nt) { bt[nt] = (bf16x8){0, 0, 0, 0, 0, 0, 0, 0};
        if (g4 < 2) bt[nt] = ld_bf16x8((const bf16*)(ws + WS_BBAR) + ((size_t)g * 128 + 16 * nt + fr) * 16 + 8 * g4); }
    float xr = 0.f, xi = 0.f;
    bf16x8 cm[4]; float dsk[4];
    if (PASS2) {
        const f32x2* xe = (const f32x2*)(ws + WS_XEND) + (size_t)((b * 32 + g) * 16) * 64 + lane;
        for (int j = 0; j < sc; ++j) { const f32x2 e = xe[j * 64]; const float nr = xr * ab.z - xi * ab.w + e.x, ni = xr * ab.w + xi * ab.z + e.y; xr = nr; xi = ni; }
#pragma unroll
        for (int ks = 0; ks < 4; ++ks) cm[ks] = ld_bf16x8((const bf16*)(ws + WS_CMAT) + (size_t)(g * 16 + fr) * 128 + 32 * ks + 8 * g4);
#pragma unroll
        for (int e = 0; e < 4; ++e) dsk[e] = a.in[I_SD][g * 16 + 4 * g4 + e];
    }
    LAS float* buL = (LAS float*)wl;
    LAS bf16* xL = (LAS bf16*)(wl + 8448);
    LAS float* uL = (LAS float*)(wl + 8448 + 4352);
    const bf16* up = (const bf16*)(ws + WS_PROJ) + ((size_t)(b * SEQ + sc * 256 + fr)) * 2048 + 1536 + g * 16 + 8 * (g4 & 1);
    bf16x8 unext = ld_bf16x8(up);
    for (int tb = 0; tb < 16; ++tb) {
        bf16x8 uc = unext;
        if (tb < 15) unext = ld_bf16x8(up + (size_t)(tb + 1) * 16 * 2048);
        if (g4 >= 2) uc = (bf16x8){0, 0, 0, 0, 0, 0, 0, 0};
        if (PASS2 && g4 < 2) { const u32x4 w = __builtin_bit_cast(u32x4, uc);
            *(LAS f32x4*)(uL + fr * 16 + 8 * g4) = (f32x4){bf_lo(w.x), bf_hi(w.x), bf_lo(w.y), bf_hi(w.y)}; *(LAS f32x4*)(uL + fr * 16 + 8 * g4 + 4) = (f32x4){bf_lo(w.z), bf_hi(w.z), bf_lo(w.w), bf_hi(w.w)}; }
#pragma unroll
        for (int nt = 0; nt < 8; ++nt) { const f32x4 z = {0.f, 0.f, 0.f, 0.f};
            const f32x4 c = __builtin_amdgcn_mfma_f32_16x16x32_bf16(uc, bt[nt], z, 0, 0, 0);
#pragma unroll
            for (int e = 0; e < 4; ++e) buL[(4 * g4 + e) * 132 + 16 * nt + fr] = c[e] + 0.0f; }
        asm volatile("" :: "v"(uc));
        LDS_WAIT(); asm volatile("" ::: "memory");
#pragma unroll 4
        for (int tl = 0; tl < 16; ++tl) {
            const float bur = buL[tl * 132 + lane], bui = buL[tl * 132 + 64 + lane];
            const float nr = ar * xr - ai * xi + bur, ni = ar * xi + ai * xr + bui; xr = nr; xi = ni;
            if (PASS2) { xL[tl * 136 + lane] = f2bf(xr); xL[tl * 136 + 64 + lane] = f2bf(xi); }
        }
        if (PASS2) {
            LDS_WAIT(); asm volatile("" ::: "memory");
            f32x4 acc = {0.f, 0.f, 0.f, 0.f};
#pragma unroll
            for (int ks = 0; ks < 4; ++ks) { const bf16x8 xb = *(const LAS bf16x8*)(xL + fr * 136 + 32 * ks + 8 * g4);
                acc = __builtin_amdgcn_mfma_f32_16x16x32_bf16(cm[ks], xb, acc, 0, 0, 0); }
            const f32x4 u4 = *(const LAS f32x4*)(uL + fr * 16 + 4 * g4);
            float y[4];
#pragma unroll
            for (int e = 0; e < 4; ++e) { const float v = acc[e] + dsk[e] * u4[e]; const float z = 1.5957691216057308f * (v + 0.044715f * v * v * v); y[e] = v * sigmoidf_(z); }
            bf16* yo = (bf16*)(ws + WS_YG) + (size_t)(b * SEQ + sc * 256 + tb * 16 + fr) * 512 + g * 16 + 4 * g4;
            *(u32x2*)yo = (u32x2){cvt_pk_bf16(y[0], y[1]), cvt_pk_bf16(y[2], y[3])};
        }
        LDS_WAIT(); asm volatile("" ::: "memory");
    }
    if (!PASS2) ((f32x2*)(ws + WS_XEND))[(size_t)((b * 32 + g) * 16 + sc) * 64 + lane] = (f32x2){xr, xi};
}

struct DilKV { bf16x8 ka[2], kb[2]; u32x4 vv[4]; };
template <int DST>
__device__ __forceinline__ void dil_load(DilKV& f, const bf16* Kb, const bf16* Vb, int t0r, int m0, int lane) {
    const int fr = lane & 15, g = lane >> 4;
    int pa = t0r + DST * (m0 + fr), pb = pa + DST * 16;
    pa = pa < 0 ? 0 : (pa > SEQ - 1 ? SEQ - 1 : pa); pb = pb < 0 ? 0 : (pb > SEQ - 1 ? SEQ - 1 : pb);
#pragma unroll
    for (int ks = 0; ks < 2; ++ks) { f.ka[ks] = ld_bf16x8(Kb + (size_t)pa * 2048 + 32 * ks + 8 * g); f.kb[ks] = ld_bf16x8(Kb + (size_t)pb * 2048 + 32 * ks + 8 * g); }
#pragma unroll
    for (int j = 0; j < 4; ++j) { int pv = t0r + DST * (m0 + (lane >> 3) + 8 * j); pv = pv < 0 ? 0 : (pv > SEQ - 1 ? SEQ - 1 : pv);
        f.vv[j] = *(const u32x4*)(Vb + (size_t)pv * 2048 + 8 * (lane & 7)); }
}
template <int DST>
__device__ __forceinline__ void dil_step(const DilKV& f, int t0r, int m0, const bf16x8 (&qf)[2], float& mrun, float& lsum, f32x4 (&o)[4], LAS unsigned char* vl, unsigned vaddr, int lane) {
    const int fr = lane & 15, g = lane >> 4;
    const int qm = (16 / DST) * fr;
    f32x4 sa = {0.f, 0.f, 0.f, 0.f}, sb = sa;
#pragma unroll
    for (int ks = 0; ks < 2; ++ks) { sa = __builtin_amdgcn_mfma_f32_16x16x32_bf16(f.ka[ks], qf[ks], sa, 0, 0, 0); sb = __builtin_amdgcn_mfma_f32_16x16x32_bf16(f.kb[ks], qf[ks], sb, 0, 0, 0); }
#pragma unroll
    for (int j = 0; j < 4; ++j) *(LAS u32x4*)(vl + ((lane >> 3) + 8 * j) * 160 + (lane & 7) * 16) = f.vv[j];
    float cmax = -INFINITY;
    const int mlo = (qm - 128) > -(t0r / DST) ? (qm - 128) : -(t0r / DST);
    const unsigned span = (unsigned)(qm - mlo); const int mb0 = m0 + 4 * g - mlo;
#pragma unroll
    for (int e = 0; e < 4; ++e) {
        const bool va = (unsigned)(mb0 + e) <= span, vb = (unsigned)(mb0 + 16 + e) <= span;
        sa[e] = va ? sa[e] : -INFINITY; sb[e] = vb ? sb[e] : -INFINITY;
        cmax = fmaxf(cmax, fmaxf(sa[e], sb[e]));
    }
    cmax = fmaxf(cmax, __shfl_xor(cmax, 16)); cmax = fmaxf(cmax, __shfl_xor(cmax, 32));
    if (__any(cmax > mrun + 64.0f)) {
        const float mnew = fmaxf(mrun, cmax), alpha = __builtin_amdgcn_exp2f((mrun - mnew) * 0.18033688011f);
        mrun = mnew; lsum *= alpha;
#pragma unroll
        for (int dt = 0; dt < 4; ++dt) o[dt] *= alpha;
    }
    const float mneg = -mrun * 0.18033688011f;
    float ps = 0.f;
#pragma unroll
    for (int e = 0; e < 4; ++e) { sa[e] = __builtin_amdgcn_exp2f(__builtin_fmaf(sa[e], 0.18033688011f, mneg)); sb[e] = __builtin_amdgcn_exp2f(__builtin_fmaf(sb[e], 0.18033688011f, mneg)); ps += sa[e] + sb[e]; }
    lsum += ps;
    bf16x8 pf;
    { const u32x4 pk = {cvt_pk_bf16(sa[0], sa[1]), cvt_pk_bf16(sa[2], sa[3]), cvt_pk_bf16(sb[0], sb[1]), cvt_pk_bf16(sb[2], sb[3])}; pf = __builtin_bit_cast(bf16x8, pk); }
    s16x4 lo[4], hi[4];
#pragma unroll
    for (int dt = 0; dt < 4; ++dt) { TRRD(lo[dt], vaddr, dt * 32); TRRD(hi[dt], vaddr, 16 * 160 + dt * 32); }
    asm volatile("s_waitcnt lgkmcnt(0)" ::: "memory"); SBAR();
#pragma unroll
    for (int dt = 0; dt < 4; ++dt) { const bf16x8 vf = {lo[dt][0], lo[dt][1], lo[dt][2], lo[dt][3], hi[dt][0], hi[dt][1], hi[dt][2], hi[dt][3]};
        o[dt] = __builtin_amdgcn_mfma_f32_16x16x32_bf16(vf, pf, o[dt], 0, 0, 0); }
}
template <int DST, int MLO, int NSTEP>
__device__ __forceinline__ void dil_branch(const bf16* Kb, const bf16* Vb, int t0r, const bf16x8 (&qf)[2], float& mrun, float& lsum, f32x4 (&o)[4], LAS unsigned char* vl, int lane) {
    const int fr = lane & 15, g = lane >> 4;
    const unsigned vaddr = (unsigned)(uintptr_t)vl + (unsigned)((4 * g + (fr >> 2)) * 160 + (fr & 3) * 8);
    DilKV f0, f1;
    dil_load<DST>(f0, Kb, Vb, t0r, MLO, lane);
#pragma unroll 1
    for (int s = 0; s < NSTEP; s += 2) {
        if (s + 1 < NSTEP) dil_load<DST>(f1, Kb, Vb, t0r, MLO + 32 * (s + 1), lane);
        dil_step<DST>(f0, t0r, MLO + 32 * s, qf, mrun, lsum, o, vl, vaddr, lane);
        if (s + 1 < NSTEP) {
            if (s + 2 < NSTEP) dil_load<DST>(f0, Kb, Vb, t0r, MLO + 32 * (s + 2), lane);
            dil_step<DST>(f1, t0r, MLO + 32 * (s + 1), qf, mrun, lsum, o, vl, vaddr, lane);
        }
    }
}
__device__ __forceinline__ void dil_unit(const Ctx& F, int b, int head, int blk, int r, LAS unsigned char* vl  ) {
    const unsigned char* ws = F.ws; const int lane = F.lane, fr = lane & 15, g = lane >> 4;
    const bf16* P = (const bf16*)(ws + WS_PROJ) + (size_t)b * SEQ * 2048 + head * 64;
    const int t0r = blk * 256 + r;
    bf16x8 qf[2];
#pragma unroll
    for (int ks = 0; ks < 2; ++ks) qf[ks] = ld_bf16x8(P + (size_t)(t0r + 16 * fr) * 2048 + 32 * ks + 8 * g);
    float mrun = -1.0e30f, lsum = 0.f;
    f32x4 o[4] = {{0.f, 0.f, 0.f, 0.f}, {0.f, 0.f, 0.f, 0.f}, {0.f, 0.f, 0.f, 0.f}, {0.f, 0.f, 0.f, 0.f}};
    dil_branch<16, -144, 5>(P + 512, P + 1024, t0r, qf, mrun, lsum, o, vl, lane);
    dil_branch<4, -128, 6>(P + 512, P + 1024, t0r, qf, mrun, lsum, o, vl, lane);
    dil_branch<1, -128, 12>(P + 512, P + 1024, t0r, qf, mrun, lsum, o, vl, lane);
    lsum += __shfl_xor(lsum, 16); lsum += __shfl_xor(lsum, 32);
    const float inv = 1.0f / lsum;
    bf16* O = (bf16*)(ws + WS_CAT) + (size_t)(b * SEQ + t0r + 16 * fr) * 1024 + head * 64 + 4 * g;
#pragma unroll
    for (int dt = 0; dt < 4; ++dt) *(u32x2*)(O + 16 * dt) = (u32x2){cvt_pk_bf16(o[dt][0] * inv, o[dt][1] * inv), cvt_pk_bf16(o[dt][2] * inv, o[dt][3] * inv)};
}

__device__ __forceinline__ void prep1_token(const Ctx& F, const Args& a, int row) {
    unsigned char* ws = F.ws; const int lane = F.lane;
    const bf16* pr = (const bf16*)(ws + WS_PROJ) + (size_t)row * 2048;
    const float* cs = (const float*)(ws + WS_ROPE) + (size_t)(row & (SEQ - 1)) * 16;
    const f32x4 c0 = *(const f32x4*)cs, c1 = *(const f32x4*)(cs + 4), s0 = *(const f32x4*)(cs + 8), s1 = *(const f32x4*)(cs + 12);
    { const u32x2 v = *(const u32x2*)(pr + 1024 + 4 * lane);
      float x[4] = {bf_lo(v.x), bf_hi(v.x), bf_lo(v.y), bf_hi(v.y)};
      const float ss = wave_sum(x[0] * x[0] + x[1] * x[1] + x[2] * x[2] + x[3] * x[3]);
      const float rstd = 1.0f / sqrtf(ss * (1.f / 256.f) + NORM_EPS);
      const f32x4 gk = *(const f32x4*)(a.in[I_GKV] + 4 * lane);
      *(u32x2*)((bf16*)(ws + WS_KOP) + (size_t)row * 272 + 4 * lane) = (u32x2){cvt_pk_bf16(x[0] * rstd * gk.x, x[1] * rstd * gk.y), cvt_pk_bf16(x[2] * rstd * gk.z, x[3] * rstd * gk.w)}; }
#define ROPE8(v, isx2) do { float _o[8]; _Pragma("unroll") for (int _e = 0; _e < 8; ++_e) _o[_e] = __shfl_xor(v[_e], 1); \
        _Pragma("unroll") for (int _e = 0; _e < 8; ++_e) { const float _c = _e < 4 ? c0[_e & 3] : c1[_e & 3], _s = _e < 4 ? s0[_e & 3] : s1[_e & 3]; \
            v[_e] = (isx2) ? v[_e] * _c + _o[_e] * _s : v[_e] * _c - _o[_e] * _s; } } while (0)
#define UNPK8(W_, v) do { v[0] = bf_lo(W_[0]); v[1] = bf_hi(W_[0]); v[2] = bf_lo(W_[1]); v[3] = bf_hi(W_[1]); v[4] = bf_lo(W_[2]); v[5] = bf_hi(W_[2]); v[6] = bf_lo(W_[3]); v[7] = bf_hi(W_[3]); } while (0)
#define PK8(v) ((u32x4){cvt_pk_bf16(v[0], v[1]), cvt_pk_bf16(v[2], v[3]), cvt_pk_bf16(v[4], v[5]), cvt_pk_bf16(v[6], v[7])})
    { const int l = lane & 31; const bool iskr = lane >= 32;
      const bf16* src = iskr ? pr + 1280 + 8 * (lane & 1) : pr + 8 * l;
      const u32x4 w = *(const u32x4*)src; float v[8]; UNPK8(w, v);
      ROPE8(v, (lane & 1));
      if (!iskr) *(u32x4*)((bf16*)(ws + WS_QOP) + ((size_t)row * 16 + (l >> 1)) * 272 + 256 + 8 * (l & 1)) = PK8(v);
      else if (lane < 34) *(u32x4*)((bf16*)(ws + WS_KOP) + (size_t)row * 272 + 256 + 8 * (lane & 1)) = PK8(v); }
    { const u32x4 w = *(const u32x4*)(pr + 1296 + 8 * lane); float v[8]; UNPK8(w, v); float r[8];
#pragma unroll
      for (int e = 0; e < 8; ++e) r[e] = v[e];
      ROPE8(r, (lane & 1));
      const bool rp = (lane & 7) < 2;
#pragma unroll
      for (int e = 0; e < 8; ++e) v[e] = rp ? r[e] : v[e];
      *(u32x4*)((bf16*)(ws + WS_QI) + (size_t)row * 512 + 8 * lane) = PK8(v); }
    { const u32x4 w = *(const u32x4*)(pr + 1808 + 8 * (lane & 7)); float v[8]; UNPK8(w, v); float r[8];
#pragma unroll
      for (int e = 0; e < 8; ++e) r[e] = v[e];
      ROPE8(r, (lane & 1));
      const bool rp = (lane & 7) < 2;
#pragma unroll
      for (int e = 0; e < 8; ++e) v[e] = rp ? r[e] : v[e];
      if (lane < 8) *(u32x4*)((bf16*)(ws + WS_KI) + (size_t)row * 64 + 8 * lane) = PK8(v);
      if (lane == 8) { const u32x4 ww = *(const u32x4*)(pr + 1872); float t[8]; UNPK8(ww, t); const float sc = 0.35355339059327373f * 0.125f;
          float* wo = (float*)(ws + WS_WI) + (size_t)row * 8; *(f32x4*)wo = (f32x4){t[0] * sc, t[1] * sc, t[2] * sc, t[3] * sc}; *(f32x4*)(wo + 4) = (f32x4){t[4] * sc, t[5] * sc, t[6] * sc, t[7] * sc}; } }
}
__device__ __forceinline__ void qlat_wave(const Ctx& F) {
    unsigned char* ws = F.ws; const int lane = F.lane, fr = lane & 15, g = lane >> 4;
    for (int wq = F.gw; wq < 2048; wq += F.NGW) {
        const int h = wq & 15;
        bf16x8 af[16][2];
#pragma unroll
        for (int ct = 0; ct < 16; ++ct)
#pragma unroll
            for (int ks = 0; ks < 2; ++ks) af[ct][ks] = ld_bf16x8((const bf16*)(ws + WS_WUK) + ((size_t)h * 256 + 16 * ct + fr) * 64 + 32 * ks + 8 * g);
        for (int tt = (wq >> 4); tt < 1024; tt += 128) {
            const bf16* qn = (const bf16*)(ws + WS_PROJ) + (size_t)(16 * tt + fr) * 2048 + 256 + 48 * h + 8 * g;
            const bf16x8 b0 = ld_bf16x8(qn);
            bf16x8 b1 = {0, 0, 0, 0, 0, 0, 0, 0};
            if (g < 2) b1 = ld_bf16x8(qn + 32);
            bf16* qo = (bf16*)(ws + WS_QOP) + ((size_t)(16 * tt + fr) * 16 + h) * 272 + 4 * g;
#pragma unroll
            for (int ct = 0; ct < 16; ++ct) {
                f32x4 acc = {0.f, 0.f, 0.f, 0.f};
                acc = __builtin_amdgcn_mfma_f32_16x16x32_bf16(af[ct][0], b0, acc, 0, 0, 0);
                acc = __builtin_amdgcn_mfma_f32_16x16x32_bf16(af[ct][1], b1, acc, 0, 0, 0);
                *(u32x2*)(qo + 16 * ct) = (u32x2){cvt_pk_bf16(acc[0], acc[1]), cvt_pk_bf16(acc[2], acc[3])};
            }
        }
    }
}
__device__ __forceinline__ void wuv_wave(const Ctx& F) {
    unsigned char* ws = F.ws; const int lane = F.lane, fr = lane & 15, g = lane >> 4;
    for (int wq = F.gw; wq < 2048; wq += F.NGW) {
        const int h = wq & 15;
        bf16x8 af[4][8];
#pragma unroll
        for (int dt = 0; dt < 4; ++dt)
#pragma unroll
            for (int ks = 0; ks < 8; ++ks) af[dt][ks] = ld_bf16x8((const bf16*)(ws + WS_WUV) + ((size_t)h * 64 + 16 * dt + fr) * 256 + 32 * ks + 8 * g);
        for (int tt = (wq >> 4); tt < 1024; tt += 128) {
            const bf16* ol = (const bf16*)(ws + WS_QOP) + ((size_t)(16 * tt + fr) * 16 + h) * 272 + 8 * g;
            bf16x8 bfv[8];
#pragma unroll
            for (int ks = 0; ks < 8; ++ks) bfv[ks] = ld_bf16x8(ol + 32 * ks);
            bf16* ao = (bf16*)(ws + WS_AOUT) + (size_t)(16 * tt + fr) * 1024 + 64 * h + 4 * g;
#pragma unroll
            for (int dt = 0; dt < 4; ++dt) {
                f32x4 acc = {0.f, 0.f, 0.f, 0.f};
#pragma unroll
                for (int ks = 0; ks < 8; ++ks) acc = __builtin_amdgcn_mfma_f32_16x16x32_bf16(af[dt][ks], bfv[ks], acc, 0, 0, 0);
                *(u32x2*)(ao + 16 * dt) = (u32x2){cvt_pk_bf16(acc[0], acc[1]), cvt_pk_bf16(acc[2], acc[3])};
            }
        }
    }
}

__device__ __forceinline__ unsigned sortkey(float x) { const unsigned u = __builtin_bit_cast(unsigned, x); return (u & 0x80000000u) ? ~u : (u | 0x80000000u); }
#ifndef DBG_NRND
#define DBG_NRND 3
#endif
template <int MODE>
__device__ __forceinline__ void indexer_tile(const Ctx& F, int b, int qt) {
    unsigned char* ws = F.ws; const int lane = F.lane, wave = F.wave, r32 = lane & 31, hf = lane >> 5;
    LAS unsigned* hist = (LAS unsigned*)F.lds;
    LAS unsigned* st = (LAS unsigned*)(F.lds + 133120);
    const int t0 = qt * 8, ntile = ((t0 + 7) >> 5) + 1, nslot = (ntile + 7) >> 3;
    const size_t rowb = (size_t)b * SEQ;
    bf16x8 qa[2][4]; float w[2][2][8];
    { const int hq = (r32 >> 2) & 1, sl = r32 >> 4, hd = (r32 & 3) + 4 * ((r32 >> 3) & 1);
#pragma unroll
      for (int G = 0; G < 2; ++G)
#pragma unroll
          for (int ks = 0; ks < 4; ++ks) qa[G][ks] = ld_bf16x8((const bf16*)(ws + WS_QI) + (rowb + t0 + 4 * G + 2 * hq + sl) * 512 + hd * 64 + 16 * ks + 8 * hf);
#pragma unroll
      for (int G = 0; G < 2; ++G)
#pragma unroll
          for (int s = 0; s < 2; ++s) { const float* wp = (const float*)(ws + WS_WI) + (rowb + t0 + 4 * G + 2 * hf + s) * 8; const f32x4 w0 = *(const f32x4*)wp, w1 = *(const f32x4*)(wp + 4);
#pragma unroll
              for (int e = 0; e < 4; ++e) { w[G][s][e] = w0[e]; w[G][s][4 + e] = w1[e]; } } }
    LAS unsigned char* kring = F.lds + wave * 16384;
    const int ns = (ntile - wave + 7) >> 3;
    const unsigned char* kbase_ = ws + WS_KI + ((rowb + 32 * wave + r32) * 64 + 8 * hf) * 2;
#define IDX_ISSUE(S_) do { _Pragma("unroll") for (int ks_ = 0; ks_ < 4; ++ks_) \
        __builtin_amdgcn_global_load_lds((const unsigned*)(kbase_ + (size_t)(S_) * (256 * 64 * 2) + 32 * ks_), (LAS unsigned*)(kring + ((S_) & 3) * 4096 + ks_ * 1024), 16, 0, 0); } while (0)
    if (0 < ns) IDX_ISSUE(0);
    if (1 < ns) IDX_ISSUE(1);
    if (2 < ns) IDX_ISSUE(2);
    unsigned sc[16][2][2];
#pragma unroll
    for (int G = 0; G < 2; ++G) {
#pragma unroll
        for (int ks = 0; ks < 4; ++ks) asm volatile("" :: "v"(qa[G][ks]));
#pragma unroll
        for (int sl = 0; sl < 2; ++sl)
#pragma unroll
            for (int hd = 0; hd < 8; ++hd) asm volatile("" :: "v"(w[G][sl][hd])); }
#pragma unroll
    for (int s = 0; s < 16; ++s) {
        const int j = wave + 8 * s;
        if (s < ns) {
            if (s + 3 < ns) IDX_ISSUE(s + 3);
            { const int rem = ns - 1 - s;
#ifdef DBG_RINGVM0
              (void)rem; asm volatile("s_waitcnt vmcnt(0)" ::: "memory");
#else
              if (rem >= 3) asm volatile("s_waitcnt vmcnt(12)" ::: "memory"); else if (rem == 2) asm volatile("s_waitcnt vmcnt(8)" ::: "memory");
              else if (rem == 1) asm volatile("s_waitcnt vmcnt(4)" ::: "memory"); else asm volatile("s_waitcnt vmcnt(0)" ::: "memory");
#endif
            }
            bf16x8 kb[4];
#pragma unroll
#ifdef DBG_NORING
            for (int ks = 0; ks < 4; ++ks) kb[ks] = ld_bf16x8((const bf16*)(kbase_ + (size_t)s * (256 * 64 * 2) + 32 * ks));
#else
            for (int ks = 0; ks < 4; ++ks) kb[ks] = *(const LAS bf16x8*)(kring + (s & 3) * 4096 + ks * 1024 + lane * 16);
#endif
            int rr_ = r32; asm volatile("" : "+v"(rr_)); const int key = 32 * j + rr_;
#pragma unroll
            for (int G = 0; G < 2; ++G) {
                f32x16 acc;
#pragma unroll
                for (int e = 0; e < 16; ++e) acc[e] = 0.f;
#pragma unroll
                for (int ks = 0; ks < 4; ++ks) acc = __builtin_amdgcn_mfma_f32_32x32x16_bf16(qa[G][ks], kb[ks], acc, 0, 0, 0);
#pragma unroll
                for (int sl = 0; sl < 2; ++sl) { float v = 0.f;
#pragma unroll
                    for (int hd = 0; hd < 8; ++hd) v += w[G][sl][hd] * fmaxf(acc[8 * sl + hd], 0.f);
                    sc[s][G][sl] = (key <= t0 + 4 * G + 2 * hf + sl) ? (unsigned)__builtin_amdgcn_fmed3f(v * 131072.0f + 1048576.0f, 0.0f, 2097151.0f) : 0xffffffffu; }
            }
            LDS_WAIT();
        } else {
#pragma unroll
            for (int G = 0; G < 2; ++G) { sc[s][G][0] = 0xffffffffu; sc[s][G][1] = 0xffffffffu; }
        }
        asm volatile("" ::: "memory"); SBAR();
    }
#undef IDX_ISSUE
    if (F.tid < 8) { const int t = t0 + F.tid; st[F.tid * 8 + 0] = 0u; st[F.tid * 8 + 1] = 0u; st[F.tid * 8 + 2] = (unsigned)(t + 1 < 256 ? t + 1 : 256); st[F.tid * 8 + 3] = 0u; st[F.tid * 8 + 4] = 1u; st[F.tid * 8 + 5] = 0u; st[F.tid * 8 + 6] = 0u; st[F.tid * 8 + 7] = 0u; }
    __syncthreads();
    if (MODE == 1) { unsigned cs = 0u;
#pragma unroll
        for (int s = 0; s < 16; ++s) cs ^= sc[s][0][0] ^ sc[s][0][1] ^ sc[s][1][0] ^ sc[s][1][1];
        ((unsigned*)(ws + WS_AOUT))[(size_t)(F.gw * 64 + lane)] = cs; return; }
    constexpr int HROW = 2052;
#pragma unroll 1
    for (int rnd = 0; rnd < DBG_NRND; ++rnd) {
#ifndef DBG_NOCAND
        if (rnd == 1) {
            LAS unsigned* clist = hist;
            int kbA = 32 * wave + r32; asm volatile("" : "+v"(kbA));
#pragma unroll
            for (int G = 0; G < 2; ++G)
#pragma unroll
                for (int sl = 0; sl < 2; ++sl) {
                    const int q = 4 * G + 2 * hf + sl;
                    const unsigned T0 = (st[q * 8 + 4] != 0u) ? (st[q * 8 + 0] >> 10) : 0xffffffffu;
#pragma unroll
                    for (int s = 0; s < 16; ++s) if (s < nslot) { unsigned sk = sc[s][G][sl]; asm volatile("" : "+v"(sk));
                        if ((sk >> 10) == T0) { const unsigned pos = __hip_atomic_fetch_add(st + q * 8 + 5, 1u, __ATOMIC_RELAXED, __HIP_MEMORY_SCOPE_WORKGROUP);
                            if (pos < 256u) clist[q * 256 + pos] = ((sk & 1023u) << 12) | (4095u - (unsigned)(kbA + 256 * s)); } }
                }
            __syncthreads();
            { const int q = wave; const unsigned c = st[q * 8 + 5], krem = st[q * 8 + 2], T0 = st[q * 8 + 0] >> 10;
              if (st[q * 8 + 4] != 0u && c <= 256u) {
                  unsigned mine[4], cnt[4];
#pragma unroll
                  for (int k4 = 0; k4 < 4; ++k4) { mine[k4] = (lane + 64 * k4 < (int)c) ? clist[q * 256 + lane + 64 * k4] : 0xffffffffu; cnt[k4] = 0u; }
                  for (unsigned j = 0; j < c; ++j) { const unsigned v = clist[q * 256 + j];
#pragma unroll
                      for (int k4 = 0; k4 < 4; ++k4) cnt[k4] += (v > mine[k4]) ? 1u : 0u; }
#pragma unroll
                  for (int k4 = 0; k4 < 4; ++k4) if (lane + 64 * k4 < (int)c && cnt[k4] == krem - 1u) {
#ifdef DBG_CANDCHK
                      st[q * 8 + 6] = (T0 << 10) | (mine[k4] >> 12); st[q * 8 + 7] = (mine[k4] & 4095u) | 0x80000000u;
#else
                      st[q * 8 + 0] = (T0 << 10) | (mine[k4] >> 12); st[q * 8 + 1] = mine[k4] & 4095u; st[q * 8 + 2] = 0u; st[q * 8 + 4] = 0u;
#endif
                  }
              } }
            __syncthreads();
        }
#endif
        if (rnd > 0) { unsigned unres = 0u;
#pragma unroll
            for (int q8 = 0; q8 < 8; ++q8) unres |= st[q8 * 8 + 4];
            if (unres == 0u) break; }
        for (int i = F.tid; i < 8 * HROW / 4; i += NTHR) ((LAS u32x4*)hist)[i] = (u32x4){0u, 0u, 0u, 0u};
        __syncthreads();
        int kbase = 32 * wave + r32; asm volatile("" : "+v"(kbase));
#pragma unroll
        for (int G = 0; G < 2; ++G)
#pragma unroll
            for (int sl = 0; sl < 2; ++sl) {
                const int q = 4 * G + 2 * hf + sl;
                const unsigned Ts = st[q * 8 + 0], Tl = st[q * 8 + 1];
                LAS unsigned* hq = hist + q * HROW;
                if (rnd == 0) {
#pragma unroll
                    for (int s = 0; s < 16; ++s) if (s < nslot) { unsigned sk = sc[s][G][sl]; asm volatile("" : "+v"(sk));
                        if (sk != 0xffffffffu) __hip_atomic_fetch_add(hq + (sk >> 10), 1u, __ATOMIC_RELAXED, __HIP_MEMORY_SCOPE_WORKGROUP); }
                } else if (rnd == 1) {
                    const unsigned T0 = (st[q * 8 + 4] != 0u) ? (Ts >> 10) : 0xffffffffu;
#pragma unroll
                    for (int s = 0; s < 16; ++s) if (s < nslot) { unsigned sk = sc[s][G][sl]; asm volatile("" : "+v"(sk));
                        if ((sk >> 10) == T0) __hip_atomic_fetch_add(hq + (((sk & 1023u) << 1) | (s < 8 ? 1u : 0u)), 1u, __ATOMIC_RELAXED, __HIP_MEMORY_SCOPE_WORKGROUP); }
                } else {
                    const bool act = st[q * 8 + 4] != 0u;
#pragma unroll
                    for (int s = 0; s < 16; ++s) if (s < nslot) { unsigned sk = sc[s][G][sl]; asm volatile("" : "+v"(sk));
                        const unsigned lo = 4095u - (unsigned)(kbase + 256 * s);
                        if (act && sk == Ts && (lo >> 11) == (Tl >> 11)) __hip_atomic_fetch_add(hq + (lo & 2047u), 1u, __ATOMIC_RELAXED, __HIP_MEMORY_SCOPE_WORKGROUP); }
                }
            }
        __syncthreads();
        { const int q = wave; const unsigned krem = st[q * 8 + 2];
          unsigned hb[32];
#pragma unroll
          for (int i4 = 0; i4 < 8; ++i4) { const u32x4 v = *(const LAS u32x4*)(hist + q * HROW + 32 * lane + 4 * i4); hb[4 * i4] = v.x; hb[4 * i4 + 1] = v.y; hb[4 * i4 + 2] = v.z; hb[4 * i4 + 3] = v.w; }
          unsigned tot = 0u;
#pragma unroll
          for (int i = 0; i < 32; ++i) tot += hb[i];
          unsigned incl = tot;
#pragma unroll
          for (int o = 1; o < 64; o <<= 1) { const unsigned tv = __shfl_down(incl, o); if (lane + o < 64) incl += tv; }
          const unsigned excl = incl - tot;
          if ((rnd == 0 || st[q * 8 + 4] != 0u) && excl < krem && krem <= incl) {
              unsigned c = excl, above = excl, hb_sel = 0u; int bsel = 0; bool found = false;
#pragma unroll
              for (int i = 31; i >= 0; --i) { if (!found) { if (c + hb[i] >= krem) { found = true; bsel = i; above = c; hb_sel = hb[i]; } c += hb[i]; } }
              const unsigned bin = (unsigned)(32 * lane + bsel);
              unsigned Ts = st[q * 8 + 0], Tl = st[q * 8 + 1];
              if (rnd == 0) Ts = bin << 10;
              else if (rnd == 1) { Ts |= bin >> 1; Tl = (bin & 1u) << 11; }
              else Tl |= bin;
              st[q * 8 + 0] = Ts; st[q * 8 + 1] = Tl; st[q * 8 + 2] = krem - above;
              st[q * 8 + 4] = (krem - above == hb_sel) ? 0u : 1u;
          } }
        __syncthreads();
    }
#ifdef DBG_CANDCHK
    if (F.tid < 8 && (st[F.tid * 8 + 7] & 0x80000000u) != 0u) {
        atomicAdd((unsigned*)(ws + WS_CTL) + 3000, 1u);
        const unsigned tr = st[F.tid * 8 + 7] & 4095u, th = st[F.tid * 8 + 1];
        const bool same = st[F.tid * 8 + 6] == st[F.tid * 8 + 0] && (tr == th || ((th & 2047u) == 0u && (tr >> 11) == (th >> 11)));
        if (!same) atomicAdd((unsigned*)(ws + WS_CTL) + 3001, 1u); }
#endif
    if (MODE == 2) { if (F.tid < 64) ((unsigned*)(ws + WS_AOUT))[(size_t)(F.vcu * 64 + F.tid)] = st[F.tid]; __syncthreads(); return; }
#ifdef DBG_TS
    if (F.tid < 8) { int* dbg = (int*)(ws + WS_AOUT) + (rowb + t0 + F.tid) * 4; dbg[0] = (int)st[F.tid * 8 + 0]; dbg[1] = (int)st[F.tid * 8 + 1]; dbg[2] = (int)st[F.tid * 8 + 2]; dbg[3] = (int)st[F.tid * 8 + 4]; }
#endif
    LAS int* keyL = (LAS int*)(F.lds + 135168);
    LAS unsigned* wtot = (LAS unsigned*)(F.lds + 133120 + 1024);
#define IDX_SEL(SK, KEY, TS, TL) ((SK) != 0xffffffffu && ((SK) > (TS) || ((SK) == (TS) && (4095u - (unsigned)(KEY)) >= (TL))))
    unsigned lpre[2][2];
#pragma unroll
    for (int G = 0; G < 2; ++G)
#pragma unroll
        for (int sl = 0; sl < 2; ++sl) {
            const int q = 4 * G + 2 * hf + sl;
            const unsigned Ts = st[q * 8 + 0], Tl = st[q * 8 + 1];
            int kbA = 32 * wave + r32; asm volatile("" : "+v"(kbA));
            unsigned c = 0u;
#pragma unroll
            for (int s = 0; s < 16; ++s) if (s < nslot) c += IDX_SEL(sc[s][G][sl], kbA + 256 * s, Ts, Tl) ? 1u : 0u;
            unsigned incl = c;
#pragma unroll
            for (int o = 1; o < 32; o <<= 1) { const unsigned tv = __shfl_up(incl, o); if (r32 >= o) incl += tv; }
            lpre[G][sl] = incl - c;
            if (r32 == 31) wtot[q * 8 + wave] = incl;
        }
    __syncthreads();
#pragma unroll
    for (int G = 0; G < 2; ++G)
#pragma unroll
        for (int sl = 0; sl < 2; ++sl) {
            const int q = 4 * G + 2 * hf + sl;
            const unsigned Ts = st[q * 8 + 0], Tl = st[q * 8 + 1];
            unsigned pos = lpre[G][sl];
#pragma unroll
            for (int w8 = 0; w8 < 7; ++w8) pos += (w8 < wave) ? wtot[q * 8 + w8] : 0u;
            LAS int* out = keyL + q * 256;
            int kbC = 32 * wave + r32; asm volatile("" : "+v"(kbC));
#pragma unroll
            for (int s = 0; s < 16; ++s) if (s < nslot) {
                unsigned skv = sc[s][G][sl]; asm volatile("" : "+v"(skv));
                const int key = kbC + 256 * s;
                if (IDX_SEL(skv, key, Ts, Tl)) { if (pos < 256u) out[pos] = key; ++pos; }
            }
        }
#undef IDX_SEL
    __syncthreads();
    { const int q = wave;
      *(u32x4*)((int*)(ws + WS_IDX) + (rowb + t0 + q) * 256 + 4 * lane) = *(const LAS u32x4*)(keyL + q * 256 + 4 * lane); }
    __syncthreads();
}

typedef short bf16x4 __attribute__((ext_vector_type(4)));
constexpr int SP_BUF = 8960, SP_WAVE = 1024 + 2 * SP_BUF;
__device__ __forceinline__ void sparse_issue(const unsigned char* KOb, const LAS unsigned* idxL, LAS unsigned char* buf, int c, int lane) {
#pragma unroll
    for (int i = 0; i < 8; ++i) { const unsigned ro = idxL[16 * c + i + 8 * (lane >> 5)];
        __builtin_amdgcn_global_load_lds((const unsigned*)(KOb + ro + 16 * (lane & 31)), (LAS unsigned*)(buf + i * 1056), 16, 0, 0); }
    if (lane < 32) { const unsigned ro = idxL[16 * c + (lane >> 1)];
        __builtin_amdgcn_global_load_lds((const unsigned*)(KOb + ro + 512 + 16 * (lane & 1)), (LAS unsigned*)(buf + 8448), 16, 0, 0); }
}
__device__ __forceinline__ void sparse_query(const Ctx& F, int row, LAS unsigned char* wl  , bf16* dummy_out = nullptr) {
    unsigned char* ws = F.ws; const int lane = F.lane, fr = lane & 15, g = lane >> 4;
    const int t = row & (SEQ - 1); const size_t rowb = (size_t)(row - t);
    const int nval = t + 1 < 256 ? t + 1 : 256, nch = (nval + 15) >> 4;
    bf16* qp = (bf16*)(ws + WS_QOP) + ((size_t)row * 16 + fr) * 272;
    LAS unsigned* idxL = (LAS unsigned*)wl;
    LAS unsigned char* buf0 = wl + 1024;
    const unsigned char* KOb = ws + WS_KOP + rowb * 544;
    { const u32x4 iv = *(const u32x4*)((const int*)(ws + WS_IDX) + (size_t)row * 256 + 4 * lane);
      u32x4 ov;
#pragma unroll
      for (int e = 0; e < 4; ++e) ov[e] = (4 * lane + e < nval) ? (iv[e] & (SEQ - 1)) * 544u : 0u;
      *(LAS u32x4*)(idxL + 4 * lane) = ov; }
    bf16x8 qf[9];
#pragma unroll
    for (int ks = 0; ks < 8; ++ks) qf[ks] = ld_bf16x8(qp + 32 * ks + 8 * g);
    qf[8] = (bf16x8){0, 0, 0, 0, 0, 0, 0, 0};
    if (g < 2) qf[8] = ld_bf16x8(qp + 256 + 8 * g);
#pragma unroll
    for (int ks = 0; ks < 9; ++ks) asm volatile("" :: "v"(qf[ks]));
    LDS_WAIT(); asm volatile("" ::: "memory");
    sparse_issue(KOb, idxL, buf0, 0, lane);
    if (nch > 1) sparse_issue(KOb, idxL, buf0 + SP_BUF, 1, lane);
    float mrun = -1.0e30f, lsum = 0.f;
    f32x4 o[16];
#pragma unroll
    for (int ct = 0; ct < 16; ++ct) o[ct] = (f32x4){0.f, 0.f, 0.f, 0.f};
    const unsigned arow = (unsigned)((fr & 7) * 1056 + (fr >> 3) * 512 + 16 * g);
    const unsigned trow = (unsigned)(((4 * g + (fr >> 2)) & 7) * 1056 + ((4 * g + (fr >> 2)) >> 3) * 512 + (fr & 3) * 8);
#pragma unroll 1
    for (int c = 0; c < nch; ++c) {
        LAS unsigned char* buf = buf0 + (c & 1) * SP_BUF;
        if (c + 1 < nch) asm volatile("s_waitcnt vmcnt(9)" ::: "memory"); else asm volatile("s_waitcnt vmcnt(0)" ::: "memory");
        f32x4 sa = {0.f, 0.f, 0.f, 0.f};
#pragma unroll
        for (int ks = 0; ks < 8; ++ks) { const bf16x8 a = *(const LAS bf16x8*)(buf + arow + 64 * ks);
            sa = __builtin_amdgcn_mfma_f32_16x16x32_bf16(a, qf[ks], sa, 0, 0, 0); }
        { bf16x8 a = {0, 0, 0, 0, 0, 0, 0, 0};
          if (g < 2) a = *(const LAS bf16x8*)(buf + 8448 + fr * 32 + 16 * g);
          sa = __builtin_amdgcn_mfma_f32_16x16x32_bf16(a, qf[8], sa, 0, 0, 0); }
        float cmax = -INFINITY;
#pragma unroll
        for (int e = 0; e < 4; ++e) { sa[e] = (16 * c + 4 * g + e < nval) ? sa[e] : -INFINITY; cmax = fmaxf(cmax, sa[e]); }
        cmax = fmaxf(cmax, __shfl_xor(cmax, 16)); cmax = fmaxf(cmax, __shfl_xor(cmax, 32));
        if (__any(cmax > mrun + 64.0f)) {
            const float mnew = fmaxf(mrun, cmax), alpha = __builtin_amdgcn_exp2f((mrun - mnew) * 0.18033688011f);
            mrun = mnew; lsum *= alpha;
#pragma unroll
            for (int ct = 0; ct < 16; ++ct) o[ct] *= alpha;
        }
        const float mneg = -mrun * 0.18033688011f;
        float ps = 0.f;
#pragma unroll
        for (int e = 0; e < 4; ++e) { sa[e] = __builtin_amdgcn_exp2f(__builtin_fmaf(sa[e], 0.18033688011f, mneg)); ps += sa[e]; }
        lsum += ps;
        bf16x4 pf;
        { const u32x2 pk = {cvt_pk_bf16(sa[0], sa[1]), cvt_pk_bf16(sa[2], sa[3])}; pf = __builtin_bit_cast(bf16x4, pk); }
        const unsigned vaddr = (unsigned)(uintptr_t)buf + trow;
#pragma unroll
        for (int c4 = 0; c4 < 2; ++c4) {
            s16x4 vt[8];
#pragma unroll
            for (int d = 0; d < 8; ++d) TRRD(vt[d], vaddr, (c4 * 8 + d) * 32);
            asm volatile("s_waitcnt lgkmcnt(0)" ::: "memory"); SBAR();
#pragma unroll
            for (int d = 0; d < 8; ++d) o[c4 * 8 + d] = __builtin_amdgcn_mfma_f32_16x16x16bf16_1k(vt[d], pf, o[c4 * 8 + d], 0, 0, 0);
        }
        if (c + 2 < nch) sparse_issue(KOb, idxL, buf, c + 2, lane);
    }
    lsum += __shfl_xor(lsum, 16); lsum += __shfl_xor(lsum, 32);
    const float inv = 1.0f / lsum;
    bf16* op = dummy_out ? dummy_out + fr * 272 : qp;
#pragma unroll
    for (int ct = 0; ct < 16; ++ct) *(u32x2*)(op + 16 * ct + 4 * g) = (u32x2){cvt_pk_bf16(o[ct][0] * inv, o[ct][1] * inv), cvt_pk_bf16(o[ct][2] * inv, o[ct][3] * inv)};
    LDS_WAIT(); asm volatile("" ::: "memory");
}

constexpr int NPHASE = 21;
#ifndef MK_PER_PHASE
#define MK_PER_PHASE 0
#endif

__device__ __forceinline__ void moe_table(const Ctx& F) {
    LAS int* tab = (LAS int*)(F.lds + MISC_OFF + 64);
    if (F.tid == 0) { int accu = 0;
        for (int e = 0; e < 8; ++e) { const int c = (int)__hip_atomic_load((unsigned*)(F.ws + WS_CTL) + CW_CNT + e, RLX_AGENT); tab[e] = c; tab[8 + e] = accu; accu += (c + 255) >> 8; }
        tab[16] = accu; }
    __syncthreads();
}

__global__ void __launch_bounds__(NTHR, 2) mk_fwd(Args args) {
    extern __shared__ __attribute__((aligned(16))) unsigned char lds_raw[];
    Ctx F;
    F.lds = (LAS unsigned char*)lds_raw;
    F.tid = threadIdx.x; F.lane = F.tid & 63; F.wave = __builtin_amdgcn_readfirstlane(F.tid >> 6);
    F.G = gridDim.x; { const int bx = blockIdx.x; F.vcu = (F.G % 8 == 0) ? (bx % 8) * (F.G / 8) + bx / 8 : bx; }
    F.gw = F.vcu * NWAVES + F.wave; F.NGW = F.G * NWAVES;
    F.ws = args.ws;
    unsigned char* ws = args.ws;
    volatile LAS unsigned* MISC = (volatile LAS unsigned*)(F.lds + MISC_OFF);
    if (F.tid < 64) MISC[F.tid] = 0u;
    __syncthreads();
    XcdBarrier bar; bar.bar = (unsigned*)(ws + WS_CTL) + CW_BAR; bar.x = 0; bar.st = nullptr; bar.wave = F.wave;
#if !MK_PER_PHASE
    bar = xcd_barrier_post((unsigned*)(ws + WS_CTL) + CW_BAR, MISC + 8, F.wave);
#define GRID_BAR() xcd_barrier(bar)
#else
#define GRID_BAR() do {} while (0)
#endif
    const int lo = args.ph_lo, hi = args.ph_hi;
#ifndef PH_MASK
#define PH_MASK 0xFFFFFFFFu
#endif
#define IN(k) ((((PH_MASK) >> (k)) & 1u) && lo <= (k) && (k) < hi)
#define FRESH() Ctx P = F; P.lane = (int)__builtin_amdgcn_mbcnt_hi(~0u, __builtin_amdgcn_mbcnt_lo(~0u, 0u)); asm volatile("" : "+v"(P.lane)); P.tid = P.wave * 64 + P.lane
#ifndef DBG_REPMASK
#define DBG_REPMASK 0u
#endif
#define REPN(k) ((((DBG_REPMASK) >> (k)) & 1u) ? 2 : 1)
#define SEAM(k) do { if (IN(k) && IN((k) + 1)) GRID_BAR(); } while (0)
    const float* MODF = (const float*)(ws + WS_MODF);
    const float* ROPE = (const float*)(ws + WS_ROPE);

    if (IN(0)) for (int rep_ = 0; rep_ < REPN(0); ++rep_) { FRESH(); p0_prologue(P, args); } SEAM(0);
    if (IN(1)) for (int rep_ = 0; rep_ < REPN(1); ++rep_) { FRESH(); for (int rb = P.gw; rb < 2048; rb += P.NGW) { Ctx Fr = P; Fr.gw = rb; norm_phase<true, false, false, false>(Fr, args, args.in[I_X], args.in[I_GMIX], 0, 0, 1024); } modf_finalize(P, args); } SEAM(1);
    if (IN(2)) for (int rep_ = 0; rep_ < REPN(2); ++rep_) { FRESH();
        pg8::Gemm g{(const bf16*)(ws + WS_U), (const bf16*)(ws + WS_WIN0), 1024}; pg8::StaticOrder S; S.init(T, 2048, 1024, P.G, (int)blockIdx.x);
        EpiProj E{(bf16*)(ws + WS_PROJ), 2048, ROPE, 4};
        pg8::gemm_phase(P.lds, g, S, E, P.wave);
    } SEAM(2);
    if (IN(3)) for (int rep_ = 0; rep_ < REPN(3); ++rep_) { FRESH();
        for (int u = P.gw; u < 1920; u += P.NGW) s5_unit<false>(P, args, u / 480, (u / 15) % 32, u % 15, P.lds + P.wave * S5_LDS);
        for (int u = P.gw; u < 8192; u += P.NGW) dil_unit(P, u >> 11, (u >> 8) & 7, (u >> 4) & 15, u & 15, P.lds + P.wave * S5_LDS);
    } SEAM(3);
    if (IN(4)) for (int rep_ = 0; rep_ < REPN(4); ++rep_) { FRESH(); for (int u = P.gw; u < 2048; u += P.NGW) s5_unit<true>(P, args, u >> 9, (u >> 4) & 31, u & 15, P.lds + P.wave * S5_LDS); } SEAM(4);
    if (IN(5)) for (int rep_ = 0; rep_ < REPN(5); ++rep_) { FRESH();
        pg8::Gemm g{(const bf16*)(ws + WS_YG), (const bf16*)(ws + WS_WGLU), 512}; pg8::StaticOrder S; S.init(T, 512, 512, P.G, (int)blockIdx.x);
        EpiGlu E{(bf16*)(ws + WS_CAT), 1024, 512, (const bf16*)(ws + WS_YG), 512, args.in[I_BGLU]};
        pg8::gemm_phase(P.lds, g, S, E, P.wave);
    } SEAM(5);
    if (IN(6)) for (int rep_ = 0; rep_ < REPN(6); ++rep_) { FRESH();
        pg8::Gemm g{(const bf16*)(ws + WS_CAT), (const bf16*)(ws + WS_WOUT0), 1024}; pg8::StaticOrder S; S.init(T, 1024, 1024, P.G, (int)blockIdx.x);
        EpiResid E{args.in[I_X], (bf16*)(ws + WS_H), MODF + 2048};
        pg8::gemm_phase(P.lds, g, S, E, P.wave);
    } SEAM(6);
    if (IN(7)) for (int rep_ = 0; rep_ < REPN(7); ++rep_) { FRESH(); for (int rb = P.gw; rb < 2048; rb += P.NGW) { Ctx Fr = P; Fr.gw = rb; norm_phase<false, false, true>(Fr, args, ws + WS_H, args.in[I_GFFN], 0, 3072, 4096); } } SEAM(7);
    if (IN(8)) for (int rep_ = 0; rep_ < REPN(8); ++rep_) { FRESH();
        pg8::Gemm g{(const bf16*)(ws + WS_U8), (const bf16*)(ws + WS_WGU0), 512}; pg8::StaticOrder S; S.init(T, 2 * FFD, 512, P.G, (int)blockIdx.x);
        EpiSwigluS E{(bf16*)(ws + WS_ACT0), FFD};
        pg8::gemm_phase<EpiSwigluS, pg8::StaticOrder, true>(P.lds, g, S, E, P.wave);
    } SEAM(8);
    if (IN(9)) for (int rep_ = 0; rep_ < REPN(9); ++rep_) { FRESH();
        pg8::Gemm g{(const bf16*)(ws + WS_ACT0), (const bf16*)(ws + WS_WDN0), FFD}; pg8::StaticOrder S; S.init(T, 1024, FFD, P.G, (int)blockIdx.x);
        EpiResidH E{(const bf16*)(ws + WS_H), (REPN(9) == 2 && rep_ == 0) ? (bf16*)(ws + 360 * MiB) : (bf16*)(ws + WS_H), MODF + 5120, 1.0f};
        pg8::gemm_phase(P.lds, g, S, E, P.wave);
    } SEAM(9);
    if (IN(10)) for (int rep_ = 0; rep_ < REPN(10); ++rep_) { FRESH(); for (int rb = P.gw; rb < 2048; rb += P.NGW) { Ctx Fr = P; Fr.gw = rb; norm_phase<false, false>(Fr, args, ws + WS_H, args.in[I_GMIX] + 1024, 1, 0, 1024); } } SEAM(10);
    if (IN(11)) for (int rep_ = 0; rep_ < REPN(11); ++rep_) { FRESH();
        pg8::Gemm g{(const bf16*)(ws + WS_U), (const bf16*)(ws + WS_WIN1), 1024}; pg8::StaticOrder S; S.init(T, 2048, 1024, P.G, (int)blockIdx.x);
        EpiProj E{(bf16*)(ws + WS_PROJ), 2048, ROPE, 0};
        pg8::gemm_phase(P.lds, g, S, E, P.wave);
    } SEAM(11);
    if (IN(12)) for (int rep_ = 0; rep_ < REPN(12); ++rep_) { FRESH(); for (int row = P.gw; row < T; row += P.NGW) prep1_token(P, args, row); qlat_wave(P); } SEAM(12);
    if (IN(13)) for (int rep_ = 0; rep_ < REPN(13); ++rep_) { FRESH(); for (int vw = P.vcu; vw < 256; vw += P.G) for (int i = 0; i < 8; ++i) indexer_tile<0>(P, i >> 1, (i & 1) ? 511 - vw : vw);
#ifdef DBG_IDXMODE
        { Ctx Q2 = P; asm volatile("" : "+v"(Q2.lane)); Q2.tid = Q2.wave * 64 + Q2.lane;
          for (int vw = Q2.vcu; vw < 256; vw += Q2.G) for (int i = 0; i < 8; ++i) indexer_tile<DBG_IDXMODE>(Q2, i >> 1, (i & 1) ? 511 - vw : vw); }
#endif
        } SEAM(13);
    if (IN(14)) for (int rep_ = 0; rep_ < REPN(14); ++rep_) { FRESH(); for (int u = P.gw; u < T; u += P.NGW) { const int b = (u & 2047) >> 9, wib = u & 511, i = u >> 11; sparse_query(P, b * SEQ + wib + 512 * i, P.lds + P.wave * SP_WAVE, (REPN(14) == 2 && rep_ == 0) ? (bf16*)(ws + WS_AOUT) + (size_t)P.gw * 4352 : nullptr); } } SEAM(14);
    if (IN(15)) for (int rep_ = 0; rep_ < REPN(15); ++rep_) { FRESH(); wuv_wave(P); } SEAM(15);
    if (IN(16)) for (int rep_ = 0; rep_ < REPN(16); ++rep_) { FRESH();
        pg8::Gemm g{(const bf16*)(ws + WS_AOUT), (const bf16*)(ws + WS_WOUT1), 1024}; pg8::StaticOrder S; S.init(T, 1024, 1024, P.G, (int)blockIdx.x);
        EpiResidH E{(const bf16*)(ws + WS_H), (REPN(16) == 2 && rep_ == 0) ? (bf16*)(ws + WS_QOP) : (bf16*)(ws + WS_H), MODF + 4 * 6144 + 2048, 1.0f};
        pg8::gemm_phase(P.lds, g, S, E, P.wave);
    } SEAM(16);
    if (IN(17)) for (int rep_ = 0; rep_ < REPN(17); ++rep_) { FRESH(); for (int rb = P.gw; rb < 2048; rb += P.NGW) { Ctx Fr = P; Fr.gw = rb; norm_phase<false, true>(Fr, args, ws + WS_H, args.in[I_GFFN] + 1024, 1, 3072, 4096); } } SEAM(17);
    if (IN(18)) for (int rep_ = 0; rep_ < REPN(18); ++rep_) { FRESH();
        moe_table(P);
        pg8::Gemm g{(const bf16*)(ws + WS_U8), (const bf16*)(ws + WS_WMGU), 512};
#ifdef DBG_NOGATHER
        MoeSched<false> S{(const LAS int*)(P.lds + MISC_OFF + 64), (const int*)(ws + WS_LIST), 28, P.G, (int)blockIdx.x, 8};
#else
        MoeSched<true> S{(const LAS int*)(P.lds + MISC_OFF + 64), (const int*)(ws + WS_LIST), 28, P.G, (int)blockIdx.x, 8};
#endif
        EpiSwiglu8 E{ws + WS_MACT, FFE};
        pg8::gemm_phase<EpiSwiglu8, decltype(S), true>(P.lds, g, S, E, P.wave);
    } SEAM(18);
    if (IN(19)) for (int rep_ = 0; rep_ < REPN(19); ++rep_) { FRESH();
        moe_table(P);
        pg8::Gemm g{(const bf16*)(ws + WS_MACT), (const bf16*)(ws + WS_WMDN), FFE / 2};
        MoeDownSched S{(const LAS int*)(P.lds + MISC_OFF + 64), P.G, (int)blockIdx.x};
        EpiMoeDown E{(bf16*)(ws + WS_YSLOT), (float*)(ws + WS_PART), (const LAS int*)(P.lds + MISC_OFF + 64), (const int*)(ws + WS_LIST), (const float*)(ws + WS_LGATE)};
        pg8::gemm_phase<EpiMoeDown, MoeDownSched, true>(P.lds, g, S, E, P.wave);
    } SEAM(19);
#ifdef DBG_XBAR
    for (int xb_ = 0; xb_ < DBG_XBAR; ++xb_) GRID_BAR();
#endif
    if (IN(20)) for (int rep_ = 0; rep_ < REPN(20); ++rep_) { FRESH(); moe_table(P); for (int rb = P.gw; rb < 2048; rb += P.NGW) { Ctx Fr = P; Fr.gw = rb; final_phase(Fr, args); } }
#undef IN
#undef SEAM
}

extern "C" void kernel_launch(void* const* d_in, const int* in_sizes, int n_in, void* d_out, int out_size, void* d_ws, size_t ws_size, hipStream_t stream) {
    static int grid = 0;
    if (grid == 0) {
        if (n_in != 32 || in_sizes[0] != T * D || out_size != T * D || ws_size < WS_END) { fprintf(stderr, "kernel_launch: unexpected shapes / workspace (n_in %d, ws %zu < %zu)\n", n_in, ws_size, (size_t)WS_END); grid = -1; return; }
        int dev = 0, cus = 0, per_cu = 0;
        if (hipGetDevice(&dev) != hipSuccess || hipDeviceGetAttribute(&cus, hipDeviceAttributeMultiprocessorCount, dev) != hipSuccess) { grid = -1; return; }
        if (hipFuncSetAttribute((const void*)mk_fwd, hipFuncAttributeMaxDynamicSharedMemorySize, LDS_BYTES) != hipSuccess) { fprintf(stderr, "kernel_launch: hipFuncSetAttribute failed\n"); grid = -1; return; }
        if (hipOccupancyMaxActiveBlocksPerMultiprocessor(&per_cu, (const void*)mk_fwd, NTHR, LDS_BYTES) != hipSuccess || per_cu < 1) { fprintf(stderr, "kernel_launch: occupancy query says %d\n", per_cu); }
        (void)hipGetLastError();
        grid = cus;
    }
    if (grid < 0) return;
    if (hipMemsetAsync((char*)d_ws + WS_CTL, 0, CTL_ZERO_BYTES, stream) != hipSuccess) return;
    Args a{};
    for (int i = 0; i < 32; ++i) a.in[i] = (const float*)d_in[i];
    a.out = (float*)d_out; a.ws = (unsigned char*)d_ws;
#if MK_PER_PHASE
#ifndef DBG_NPH
#define DBG_NPH NPHASE
#endif
    for (int p = 0; p < DBG_NPH; ++p) { a.ph_lo = p; a.ph_hi = p + 1; hipLaunchKernelGGL(mk_fwd, dim3(grid), dim3(NTHR), LDS_BYTES, stream, a); }
#else
#ifdef DBG_NPH
    a.ph_lo = 0; a.ph_hi = DBG_NPH; hipLaunchKernelGGL(mk_fwd, dim3(grid), dim3(NTHR), LDS_BYTES, stream, a);
#else
    a.ph_lo = 0; a.ph_hi = NPHASE; hipLaunchKernelGGL(mk_fwd, dim3(grid), dim3(NTHR), LDS_BYTES, stream, a);
#endif
#endif
}
```

```cpp
#include <hip/hip_runtime.h>
#include <cstdio>
#include <cstdint>

#define LAS __attribute__((address_space(3)))
#define GAS __attribute__((address_space(1)))
typedef unsigned short bf16;
typedef short bf16x8 __attribute__((ext_vector_type(8)));
typedef short s16x4 __attribute__((ext_vector_type(4)));
typedef float f32x4 __attribute__((ext_vector_type(4)));
typedef float f32x2 __attribute__((ext_vector_type(2)));
typedef float f32x16 __attribute__((ext_vector_type(16)));
typedef unsigned u32x4 __attribute__((ext_vector_type(4)));
typedef unsigned u32x2 __attribute__((ext_vector_type(2)));

typedef __bf16 bf16x2_t __attribute__((ext_vector_type(2)));
__device__ __forceinline__ unsigned cvt_pk_bf16(float lo, float hi) { const f32x2 v = {lo, hi}; const bf16x2_t r = __builtin_convertvector(v, bf16x2_t); return __builtin_bit_cast(unsigned, r); }
__device__ __forceinline__ float sat448(float x) { return __builtin_amdgcn_fmed3f(x, -448.0f, 448.0f); }
__device__ __forceinline__ unsigned cvt_pk4_fp8(float a, float b, float c, float d) { int p = __builtin_amdgcn_cvt_pk_fp8_f32(sat448(a), sat448(b), 0, false); p = __builtin_amdgcn_cvt_pk_fp8_f32(sat448(c), sat448(d), p, true); return (unsigned)p; }
__device__ __forceinline__ float bf_lo(unsigned u) { return __builtin_bit_cast(float, u << 16); }
__device__ __forceinline__ float bf_hi(unsigned u) { return __builtin_bit_cast(float, u & 0xffff0000u); }
__device__ __forceinline__ float bf2f(bf16 v) { return __builtin_bit_cast(float, (unsigned)v << 16); }
__device__ __forceinline__ bf16 f2bf(float f) { return (bf16)(cvt_pk_bf16(f, 0.f) & 0xffffu); }
__device__ __forceinline__ float fast_exp(float x) { return __builtin_amdgcn_exp2f(x * 1.44269504089f); }
__device__ __forceinline__ float fast_rcp(float x) { return __builtin_amdgcn_rcpf(x); }
__device__ __forceinline__ float sigmoidf_(float x) { return fast_rcp(1.f + fast_exp(-x)); }

#ifdef DBG_NOGATHER
#define PMA(x) ((x) & 63)
#else
#define PMA(x) (x)
#endif
namespace pg8 {
constexpr int BM = 256, BK = 64, HALF = 128, HTB = HALF * BK * 2, STAGE_BYTES = 8 * HTB, NXCD = 8, WGM = 8;
__host__ __device__ __forceinline__ int lds_byte(int r, int c) { const int st = (r >> 4) * 2 + (c >> 5), rr = r & 15, cc = c & 31, ob = rr * 64 + cc * 2; return st * 1024 + (ob ^ (((ob >> 9) & 1) << 5)); }
__host__ __device__ __forceinline__ void stage_rc(int b, int& R, int& C) { const int st = b / 1024, sb = b % 1024, swz = sb ^ (((sb >> 9) & 1) << 5); R = (st >> 1) * 16 + swz / 64; C = (st & 1) * 32 + (swz % 64) / 2; }
__host__ __device__ __forceinline__ int perm32(int rho) { const int n = rho >> 4, i = rho & 15; return 8 * (i >> 2) + 4 * n + (i & 3); }

struct Unit { int pm, pn, pb, kt0, nkt; };
struct Gemm { const bf16* A; const bf16* Bt; int K; };

struct StaticOrder {
    static constexpr bool GATHER = false;
    int nM, nN, nwg, G, c;
    int nktf;
    __device__ void init(int M, int N, int K, int G_, int c_) { nM = M / BM; nN = N / BM; nwg = nM * nN; G = G_; c = c_; nktf = K / BK; }
    __device__ bool next(int i, Unit& u) const {
        const long L = (long)i * G + c; if (L >= nwg) return false;
        int wgid = (int)L; { const int q = nwg / NXCD, r = nwg % NXCD, xcd = wgid % NXCD, off = wgid / NXCD; wgid = (xcd < r ? xcd * (q + 1) : r * (q + 1) + (xcd - r) * q) + off; }
        const int nig = WGM * nN, gid = wgid / nig, fm = gid * WGM, gsz = (nM - fm) < WGM ? (nM - fm) : WGM;
        u.pm = fm + ((wgid % nig) % gsz); u.pn = (wgid % nig) / gsz; u.pb = u.pn; u.kt0 = 0; u.nkt = nktf; return true;
    }
    __device__ __forceinline__ unsigned arow(const Unit&, int) const { return 0u; }
};

typedef int v8i __attribute__((ext_vector_type(8)));
template <class Epi, class Sched, bool FP8 = false, bool PAD = false>
__device__ __forceinline__ void gemm_phase(LAS unsigned char* lds, const Gemm g, const Sched& S, const Epi& E, int wave_id) {
    constexpr bool GA = Sched::GATHER;
    int tid_ = wave_id * 64 + (int)__builtin_amdgcn_mbcnt_hi(~0u, __builtin_amdgcn_mbcnt_lo(~0u, 0u)); asm volatile("" : "+v"(tid_));
    const int tid = tid_, wid = __builtin_amdgcn_readfirstlane(tid >> 6), lane = tid & 63, wr = wid >> 2, wc = wid & 3, fr = lane & 15, fq = lane >> 4;
    const int K = g.K;
    unsigned voffA[2], voffB[2]; int RA[2], CA[2];
#pragma unroll
    for (int i = 0; i < 2; ++i) { int R, C; stage_rc(tid * 16 + i * 8192, R, C); const int Rb = (R & ~31) + perm32(R & 31);
        RA[i] = R; CA[i] = C; voffA[i] = (unsigned)(R * K + C) * 2u; voffB[i] = (unsigned)(Rb * K + C) * 2u; }
    const size_t kstep = (size_t)(BK * 2);
    const size_t hstep = (size_t)HALF * K * 2;
    const size_t tstep = 2 * hstep;
    const unsigned ldsw = (unsigned)wid * 1024u;
    const int aoff = lds_byte(wr * 64 + fr, FP8 ? fq * 16 : fq * 8), boff = lds_byte(wc * 32 + fr, FP8 ? fq * 16 : fq * 8);
    const int scale1 = 0x7f7f7f7f;
    constexpr int KOFF = FP8 ? 16 : 1024;
    unsigned cv[2][2], nv[2][2];
#define PG8_SA(b, h) (((b) * 2 + (h)) * HTB)
#define PG8_SB(b, h) ((4 + (b) * 2 + (h)) * HTB)
#define PG8_STAGE(bufoff, gbase, voff) do { _Pragma("unroll") for (int _i = 0; _i < 2; ++_i) \
        __builtin_amdgcn_global_load_lds((const unsigned*)((const char*)(gbase) + (voff)[_i]), (LAS unsigned*)(lds + (bufoff) + ldsw + _i * 8192), 16, 0, 0); } while (0)
#define PG8_STAGE_A(bufoff, p, h, NX) do { if constexpr (GA) { unsigned _v[2]; _v[0] = (NX) ? nv[h][0] : cv[h][0]; _v[1] = (NX) ? nv[h][1] : cv[h][1]; PG8_STAGE(bufoff, p, _v); } \
        else { PG8_STAGE(bufoff, (p) + ((h) ? hstep : 0), voffA); } } while (0)
#define PG8_LD8(p) ({ const u32x4 _lo = *(const LAS u32x4*)(p), _hi = *(const LAS u32x4*)((p) + KOFF); (v8i){(int)_lo.x, (int)_lo.y, (int)_lo.z, (int)_lo.w, (int)_hi.x, (int)_hi.y, (int)_hi.z, (int)_hi.w}; })
#define PG8_LDA(dst, b, h) do { _Pragma("unroll") for (int m = 0; m < 4; ++m) dst[m] = PG8_LD8(lds + PG8_SA(b, h) + aoff + m * 2048); } while (0)
#define PG8_LDB(dst, b, h) do { _Pragma("unroll") for (int n = 0; n < 2; ++n) dst[n] = PG8_LD8(lds + PG8_SB(b, h) + boff + n * 2048); } while (0)
#define PG8_HALF(X, k) __builtin_bit_cast(bf16x8, (k) ? __builtin_shufflevector(X, X, 4, 5, 6, 7) : __builtin_shufflevector(X, X, 0, 1, 2, 3))
#define PG8_MMA(ai, bj, At, Bt) do { __builtin_amdgcn_s_setprio(1); \
        if constexpr (FP8) { _Pragma("unroll") for (int m = 0; m < 4; ++m) _Pragma("unroll") for (int n = 0; n < 2; ++n) \
            asm volatile("v_mfma_scale_f32_16x16x128_f8f6f4 %0, %1, %2, %0, %3, %3 op_sel_hi:[0,0,0]" : "+v"(acc[ai][bj][m][n]) : "v"(Bt[n]), "v"(At[m]), "v"(scale1)); \
            if constexpr (PAD) asm volatile("s_nop 7\n\ts_nop 3" ::: "memory"); }   \
        else { _Pragma("unroll") for (int m = 0; m < 4; ++m) _Pragma("unroll") for (int n = 0; n < 2; ++n) _Pragma("unroll") for (int k = 0; k < 2; ++k) \
            acc[ai][bj][m][n] = __builtin_amdgcn_mfma_f32_16x16x32_bf16(PG8_HALF(Bt[n], k), PG8_HALF(At[m], k), acc[ai][bj][m][n], 0, 0, 0); } \
        __builtin_amdgcn_s_setprio(0); } while (0)
#ifdef DBG_VM0
#define PG8_WAIT_V(n) do { if constexpr (GA) asm volatile("s_waitcnt vmcnt(0)" ::: "memory"); else asm volatile("s_waitcnt vmcnt(" #n ")" ::: "memory"); } while (0)
#else
#define PG8_WAIT_V(n) asm volatile("s_waitcnt vmcnt(" #n ")" ::: "memory")
#endif
#define PG8_WAIT_L(n) asm volatile("s_waitcnt lgkmcnt(" #n ")" ::: "memory")
#define PG8_BAR __builtin_amdgcn_s_barrier()
#define PG8_SCHED __builtin_amdgcn_sched_barrier(0)
#define PG8_GROWS(dst, u) do { if constexpr (GA) { _Pragma("unroll") for (int _h = 0; _h < 2; ++_h) _Pragma("unroll") for (int _i = 0; _i < 2; ++_i) \
        dst[_h][_i] = (S.arow(u, _h * HALF + RA[_i]) * (unsigned)K + (unsigned)CA[_i]) * 2u; } } while (0)
    Unit cur, nxt; int ui = 0;
    if (!S.next(0, cur)) return;
    f32x4 acc[2][2][4][2];
    v8i At[4], B0[2], B1[2];
    int nt = cur.nkt;
    const char* cA = (GA ? (const char*)g.A : (const char*)g.A + (size_t)PMA(cur.pm) * tstep) + (size_t)cur.kt0 * kstep; const char* cB = (const char*)g.Bt + (size_t)cur.pb * tstep + (size_t)cur.kt0 * kstep;
    PG8_GROWS(cv, cur);
#pragma unroll
    for (int _h = 0; _h < 2; ++_h) { nv[_h][0] = cv[_h][0]; nv[_h][1] = cv[_h][1]; }
    PG8_STAGE(PG8_SB(0, 0), cB, voffB); PG8_STAGE(PG8_SB(0, 1), cB + hstep, voffB); PG8_STAGE_A(PG8_SA(0, 0), cA, 0, false); PG8_STAGE_A(PG8_SA(0, 1), cA, 1, false);
    if (wr == 1) PG8_BAR;
    PG8_WAIT_V(2); PG8_BAR;
    PG8_STAGE(PG8_SB(1, 0), cB + kstep, voffB); PG8_STAGE_A(PG8_SA(1, 0), cA + kstep, 0, false); PG8_STAGE(PG8_SB(1, 1), cB + hstep + kstep, voffB);
    PG8_WAIT_V(6); PG8_BAR;
#pragma unroll
    for (int a = 0; a < 2; ++a)
#pragma unroll
        for (int b = 0; b < 2; ++b)
#pragma unroll
            for (int m = 0; m < 4; ++m)
#pragma unroll
                for (int n = 0; n < 2; ++n) acc[a][b][m][n] = (f32x4){0.f, 0.f, 0.f, 0.f};
    for (;;) {
        const bool has_next = S.next(ui + 1, nxt);
        const char* nA = has_next ? (GA ? (const char*)g.A : (const char*)g.A + (size_t)PMA(nxt.pm) * tstep) + (size_t)nxt.kt0 * kstep : cA; const char* nB = has_next ? (const char*)g.Bt + (size_t)nxt.pb * tstep + (size_t)nxt.kt0 * kstep : cB;
        if (has_next) { PG8_GROWS(nv, nxt); }
        for (int t = 0; t < nt; t += 2) {
            const bool last = (t == nt - 2);
            const char* a1 = cA + (size_t)(t + 1) * kstep;
            const char* a2 = last ? nA : cA + (size_t)(t + 2) * kstep; const char* b2 = last ? nB : cB + (size_t)(t + 2) * kstep;
            const char* a3 = a2 + kstep; const char* b3 = b2 + kstep;
            PG8_LDB(B0, 0, 0); PG8_LDB(B1, 0, 1); PG8_SCHED; PG8_LDA(At, 0, 0); PG8_STAGE_A(PG8_SA(1, 1), a1, 1, false);
            PG8_WAIT_V(8); PG8_WAIT_L(0); PG8_BAR; PG8_MMA(0, 0, At, B0); PG8_MMA(0, 1, At, B1); PG8_BAR; PG8_SCHED;
            PG8_LDA(At, 0, 1); PG8_STAGE(PG8_SB(0, 0), b2, voffB); PG8_STAGE(PG8_SB(0, 1), b2 + hstep, voffB); PG8_STAGE_A(PG8_SA(0, 0), a2, 0, last);
            PG8_WAIT_V(8); PG8_WAIT_L(0); PG8_BAR; PG8_MMA(1, 0, At, B0); PG8_MMA(1, 1, At, B1); PG8_BAR; PG8_SCHED;
            PG8_LDB(B0, 1, 0); PG8_LDB(B1, 1, 1); PG8_SCHED; PG8_LDA(At, 1, 0); PG8_STAGE_A(PG8_SA(0, 1), a2, 1, last);
            PG8_WAIT_V(8); PG8_WAIT_L(0); PG8_BAR; PG8_MMA(0, 0, At, B0); PG8_MMA(0, 1, At, B1); PG8_BAR; PG8_SCHED;
            PG8_LDA(At, 1, 1); PG8_STAGE(PG8_SB(1, 0), b3, voffB); PG8_STAGE(PG8_SB(1, 1), b3 + hstep, voffB); PG8_STAGE_A(PG8_SA(1, 0), a3, 0, last);
            PG8_WAIT_V(8); PG8_WAIT_L(0); PG8_BAR; PG8_MMA(1, 0, At, B0); PG8_MMA(1, 1, At, B1); PG8_BAR; PG8_SCHED;
        }
        if constexpr (FP8) asm volatile("s_nop 7\n\ts_nop 7\n\ts_nop 7\n\ts_nop 7\n\ts_nop 7\n\ts_nop 7\n\ts_nop 7\n\ts_nop 7" ::: "memory");
        if (wr == 0) PG8_BAR;
        E(acc, cur, wr, wc, fr, fq);
        if (!has_next) break;
#pragma unroll
        for (int a = 0; a < 2; ++a)
#pragma unroll
            for (int b = 0; b < 2; ++b)
#pragma unroll
                for (int m = 0; m < 4; ++m)
#pragma unroll
                    for (int n = 0; n < 2; ++n) acc[a][b][m][n] = (f32x4){0.f, 0.f, 0.f, 0.f};
        cur = nxt; cA = nA; cB = nB; ++ui; nt = cur.nkt;
#pragma unroll
        for (int _h = 0; _h < 2; ++_h) { cv[_h][0] = nv[_h][0]; cv[_h][1] = nv[_h][1]; }
        if (wr == 1) PG8_BAR;
    }
    PG8_WAIT_V(0);
    PG8_BAR;
#undef PG8_SA
#undef PG8_SB
#undef PG8_STAGE
#undef PG8_STAGE_A
#undef PG8_LDA
#undef PG8_LDB
#undef PG8_MMA
#undef PG8_HALF
#undef PG8_LD8
#undef PG8_WAIT_V
#undef PG8_WAIT_L
#undef PG8_BAR
#undef PG8_SCHED
#undef PG8_GROWS
}
}

constexpr int NB = 4, SEQ = 4096, T = NB * SEQ, D = 1024;
constexpr int FFD = 2816, FFE = 3584, NEXP = 8;
constexpr int CIN = 1880;
constexpr int NWAVES = 8, NTHR = 512;
constexpr float NORM_EPS = 1e-6f;

constexpr size_t MiB = 1u << 20;
constexpr size_t WS_CTL = 0, CTL_ZERO_BYTES = 1 * MiB;
constexpr size_t WS_MODP = 1 * MiB;
constexpr size_t WS_MODF = 4 * MiB;
constexpr size_t WS_ROPE = 4 * MiB + 256 * 1024;
constexpr size_t WS_ABAR = 4 * MiB + 512 * 1024;
constexpr size_t WS_BBAR = 4 * MiB + 576 * 1024;
constexpr size_t WS_CMAT = 5 * MiB;
constexpr size_t WS_XEND = 5 * MiB + 256 * 1024;
constexpr size_t WS_WUK  = 6 * MiB + 512 * 1024;
constexpr size_t WS_WUV  = 7 * MiB;
constexpr size_t WS_LIST = 7 * MiB + 512 * 1024;
constexpr size_t WS_LGATE = 8 * MiB;
constexpr size_t WS_KI   = 9 * MiB;
constexpr size_t WS_WI   = 11 * MiB;
constexpr size_t WS_WIN0 = 16 * MiB;
constexpr size_t WS_WOUT0 = 20 * MiB;
constexpr size_t WS_WGLU = 22 * MiB;
constexpr size_t WS_WGU0 = 23 * MiB;
constexpr size_t WS_WDN0 = 34 * MiB;
constexpr size_t WS_WIN1 = 40 * MiB;
constexpr size_t WS_WOUT1 = 44 * MiB;
constexpr size_t WS_WMGU = 46 * MiB;
constexpr size_t WS_WMDN = 102 * MiB;
constexpr size_t WS_H = 136 * MiB;
constexpr size_t WS_U = 216 * MiB;
constexpr size_t WS_PROJ = 248 * MiB;
constexpr size_t WS_CAT = 312 * MiB;
constexpr size_t WS_YG = 344 * MiB;
constexpr size_t WS_ACT0 = 248 * MiB;
constexpr size_t WS_QOP = 312 * MiB;
constexpr size_t WS_KOP = 448 * MiB;
constexpr size_t WS_QI = 457 * MiB;
constexpr size_t WS_IDX = 248 * MiB;
constexpr size_t WS_AOUT = 264 * MiB;
constexpr size_t WS_MACT = 248 * MiB;
constexpr size_t WS_U8 = 216 * MiB;
constexpr size_t WS_PART = 232 * MiB;
constexpr size_t WS_YSLOT = 16 * MiB;
constexpr size_t WS_END = 486 * MiB;
constexpr int MACT_ROWS = 34816;

constexpr int CW_CNT = 64;
constexpr int CW_BAR = 4096;

constexpr int RING_BYTES = 131072;
constexpr int MISC_OFF = 151552;
constexpr int LDS_BYTES = 152576;

#define RLX_AGENT __ATOMIC_RELAXED, __HIP_MEMORY_SCOPE_AGENT
#define LDS_WAIT() asm volatile("s_waitcnt lgkmcnt(0)" ::: "memory")
#define VM_WAIT() asm volatile("s_waitcnt vmcnt(0)" ::: "memory")
#define SBAR() __builtin_amdgcn_sched_barrier(0)

#define XB_TMO      128
#define XB_XCNT(j)  (256  + 64 * (j))
#define XB_XSUB(j)  (1280 + 64 * (j))
#define XB_XGEN(j)  (2304 + 64 * (j))
#define XB_TOP      3328
#define XB_TOPGEN   3392
#define XCD_BAR_WORDS 3456
#define XB_SPIN_CAP (1u << 22)

__device__ __forceinline__ unsigned xb_ld(unsigned* p)              { return __hip_atomic_load(p, __ATOMIC_RELAXED, __HIP_MEMORY_SCOPE_AGENT); }
__device__ __forceinline__ unsigned xb_add(unsigned* p, unsigned v) { return __hip_atomic_fetch_add(p, v, __ATOMIC_RELAXED, __HIP_MEMORY_SCOPE_AGENT); }
__device__ __forceinline__ unsigned xb_xcc_id() { return (unsigned)__builtin_amdgcn_s_getreg((3 << 11) | 20) & 0xFu; }
#define XB_SPIN(cond, bar) do { unsigned _sp = 0; while (cond) { __builtin_amdgcn_s_sleep(1); \
    if ((++_sp & 255u) == 0u) { if (xb_ld(&(bar)[XB_TMO])) break; if (_sp > XB_SPIN_CAP) { atomicAdd(&(bar)[XB_TMO], 1u); break; } } } } while (0)

struct XcdBarrier { unsigned* bar; unsigned x; volatile LAS unsigned* st; int wave; };
__device__ __forceinline__ int lane_id_() { return (int)__builtin_amdgcn_mbcnt_hi(~0u, __builtin_amdgcn_mbcnt_lo(~0u, 0u)); }

__device__ __forceinline__ XcdBarrier xcd_barrier_post(unsigned* bar, volatile LAS unsigned* st, int wave) {
    XcdBarrier b; b.bar = bar; b.x = xb_xcc_id(); b.st = st; b.wave = wave;
    if (wave == 0 && lane_id_() == 0) (void)xb_add(&bar[XB_XCNT(b.x)], 1u);
    return b;
}
__device__ __forceinline__ void xcd_barrier_complete(unsigned* bar, unsigned x, unsigned& nloc, unsigned& nx) {
    const unsigned G = gridDim.x * gridDim.y * gridDim.z;
    unsigned sum, cnt, mine, sp = 0u;
    for (;;) {
        sum = 0u; cnt = 0u; mine = 0u;
#pragma unroll
        for (unsigned j = 0; j < 16; ++j) { const unsigned c = xb_ld(&bar[XB_XCNT(j)]); sum += c; cnt += (c > 0u) ? 1u : 0u; mine = (j == x) ? c : mine; }
        if (sum == G) break;
        __builtin_amdgcn_s_sleep(1);
        if ((++sp & 255u) == 0u) { if (xb_ld(&bar[XB_TMO])) break; if (sp > XB_SPIN_CAP) { atomicAdd(&bar[XB_TMO], 1u); break; } }
    }
    nloc = mine > 0u ? mine : 1u; nx = cnt > 0u ? cnt : 1u;
}
__device__ __forceinline__ void xcd_barrier(const XcdBarrier& b) {
    asm volatile("s_waitcnt vmcnt(0)" ::: "memory");
    __syncthreads();
    if (b.wave == 0 && lane_id_() == 0) {
        unsigned* bar = b.bar;
        __builtin_amdgcn_s_waitcnt(0);
        unsigned nloc = b.st[0], nx = b.st[1];
        if (nloc == 0u) { xcd_barrier_complete(bar, b.x, nloc, nx); b.st[0] = nloc; b.st[1] = nx; }
        const unsigned old = xb_add(&bar[XB_XSUB(b.x)], 1u);
        const unsigned gen = old / nloc;
        if (old + 1u == (gen + 1u) * nloc) {
            __builtin_amdgcn_fence(__ATOMIC_RELEASE, "agent");
            asm volatile("s_waitcnt vmcnt(0)" ::: "memory");
            const unsigned og = xb_add(&bar[XB_TOP], 1u);
            const unsigned tg = og / nx;
            if (og + 1u == (tg + 1u) * nx) xb_add(&bar[XB_TOPGEN], 1u);
            else XB_SPIN(xb_ld(&bar[XB_TOPGEN]) == tg, bar);
            __builtin_amdgcn_fence(__ATOMIC_ACQUIRE, "agent");
            xb_add(&bar[XB_XGEN(b.x)], 1u);
            asm volatile("s_waitcnt vmcnt(0)" ::: "memory");
        } else {
            XB_SPIN(xb_ld(&bar[XB_XGEN(b.x)]) == gen, bar);
            __builtin_amdgcn_fence(__ATOMIC_ACQUIRE, "agent");
            asm volatile("s_waitcnt vmcnt(0)" ::: "memory");
        }
    }
    __syncthreads();
}

__device__ __forceinline__ float wave_sum(float v) {
#pragma unroll
    for (int o = 1; o < 64; o <<= 1) v += __shfl_xor(v, o);
    return v;
}

struct Args { const float* in[32]; float* out; unsigned char* ws; int ph_lo, ph_hi; };
enum { I_X = 0, I_C, I_WADA, I_BADA, I_GMIX, I_GFFN, I_GFINAL, I_EWIN, I_EWOUT, I_ARE, I_AIM, I_LOGDT, I_BRE, I_BIM, I_CRE, I_CIM, I_SD, I_WGLU, I_BGLU,
       I_FFG, I_FFU, I_FFD, I_OWIN, I_OWOUT, I_GKV, I_WUK, I_WUV, I_ROUTER, I_BROUTER, I_MG, I_MU, I_MD };

struct Ctx {
    LAS unsigned char* lds;
    int tid, lane, wave, G, vcu, gw, NGW;
    unsigned char* ws;
};

using pg8::Unit;

struct EpiProj {
    bf16* O; int ldc; const float* cs; int rope_tiles;
    __device__ __forceinline__ void operator()(const f32x4 (&acc)[2][2][4][2], const Unit& u, int wr, int wc, int fr, int fq) const {
        const int row0 = u.pm * 256 + wr * 64 + fr, col0 = u.pn * 256 + wc * 32 + fq * 8;
        const bool rope = (u.pn < rope_tiles) && ((wc & 1) == 0);
#pragma unroll
        for (int ai = 0; ai < 2; ++ai)
#pragma unroll
            for (int m = 0; m < 4; ++m) {
                const int row = row0 + ai * 128 + m * 16;
                f32x4 c0 = {1.f, 1.f, 1.f, 1.f}, c1 = c0, s0 = {0.f, 0.f, 0.f, 0.f}, s1 = s0;
                if (rope) { const f32x4* p = (const f32x4*)(cs + (size_t)(row & (SEQ - 1)) * 16); c0 = p[0]; c1 = p[1]; s0 = p[2]; s1 = p[3]; }
#pragma unroll
                for (int bj = 0; bj < 2; ++bj) {
                    f32x4 v0 = acc[ai][bj][m][0], v1 = acc[ai][bj][m][1];
                    if (rope) {
                        f32x4 o0, o1;
#pragma unroll
                        for (int e = 0; e < 4; ++e) { o0[e] = __shfl_xor(v0[e], 16); o1[e] = __shfl_xor(v1[e], 16); }
                        if (fq == 0) { v0 = v0 * c0 - o0 * s0; v1 = v1 * c1 - o1 * s1; }
                        else if (fq == 1) { v0 = v0 * c0 + o0 * s0; v1 = v1 * c1 + o1 * s1; }
                    }
                    u32x4 w; w.x = cvt_pk_bf16(v0[0], v0[1]); w.y = cvt_pk_bf16(v0[2], v0[3]); w.z = cvt_pk_bf16(v1[0], v1[1]); w.w = cvt_pk_bf16(v1[2], v1[3]);
                    *(u32x4*)(O + (size_t)row * ldc + col0 + bj * 128) = w;
                }
            }
    }
};

struct EpiGlu {
    bf16* O; int ldc, coff; const bf16* Y; int ldy; const float* bias;
    __device__ __forceinline__ void operator()(const f32x4 (&acc)[2][2][4][2], const Unit& u, int wr, int wc, int fr, int fq) const {
        const int row0 = u.pm * 256 + wr * 64 + fr, col0 = u.pn * 256 + wc * 32 + fq * 8;
#pragma unroll
        for (int bj = 0; bj < 2; ++bj) {
            const int col = col0 + bj * 128;
            const f32x4 b0 = *(const f32x4*)(bias + col), b1 = *(const f32x4*)(bias + col + 4);
#pragma unroll
            for (int ai = 0; ai < 2; ++ai)
#pragma unroll
                for (int m = 0; m < 4; ++m) {
                    const int row = row0 + ai * 128 + m * 16;
                    const u32x4 yv = *(const u32x4*)(Y + (size_t)row * ldy + col);
                    const f32x4 v0 = acc[ai][bj][m][0] + b0, v1 = acc[ai][bj][m][1] + b1;
                    float r[8];
                    r[0] = bf_lo(yv.x) * sigmoidf_(v0[0]); r[1] = bf_hi(yv.x) * sigmoidf_(v0[1]); r[2] = bf_lo(yv.y) * sigmoidf_(v0[2]); r[3] = bf_hi(yv.y) * sigmoidf_(v0[3]);
                    r[4] = bf_lo(yv.z) * sigmoidf_(v1[0]); r[5] = bf_hi(yv.z) * sigmoidf_(v1[1]); r[6] = bf_lo(yv.w) * sigmoidf_(v1[2]); r[7] = bf_hi(yv.w) * sigmoidf_(v1[3]);
                    u32x4 w; w.x = cvt_pk_bf16(r[0], r[1]); w.y = cvt_pk_bf16(r[2], r[3]); w.z = cvt_pk_bf16(r[4], r[5]); w.w = cvt_pk_bf16(r[6], r[7]);
                    *(u32x4*)(O + (size_t)row * ldc + coff + col) = w;
                }
        }
    }
};

__device__ __forceinline__ u32x4 pack8_bf16(const f32x4 a, const f32x4 b) { return (u32x4){cvt_pk_bf16(a[0], a[1]), cvt_pk_bf16(a[2], a[3]), cvt_pk_bf16(b[0], b[1]), cvt_pk_bf16(b[2], b[3])}; }
struct EpiResid {
    const float* base; bf16* out; const float* gate;
    __device__ __forceinline__ void operator()(const f32x4 (&acc)[2][2][4][2], const Unit& u, int wr, int wc, int fr, int fq) const {
        const int row0 = u.pm * 256 + wr * 64 + fr, col0 = u.pn * 256 + wc * 32 + fq * 8;
        const int b = (u.pm * 256) >> 12;
#pragma unroll
        for (int bj = 0; bj < 2; ++bj) {
            const int col = col0 + bj * 128;
            const f32x4 g0 = *(const f32x4*)(gate + b * 6144 + col), g1 = *(const f32x4*)(gate + b * 6144 + col + 4);
#pragma unroll
            for (int ai = 0; ai < 2; ++ai)
#pragma unroll
                for (int m = 0; m < 4; ++m) {
                    const size_t off = (size_t)(row0 + ai * 128 + m * 16) * D + col;
                    const f32x4 x0 = *(const f32x4*)(base + off), x1 = *(const f32x4*)(base + off + 4);
                    *(u32x4*)(out + off) = pack8_bf16(x0 + g0 * acc[ai][bj][m][0], x1 + g1 * acc[ai][bj][m][1]);
                }
        }
    }
};
struct EpiResidH {
    const bf16* base; bf16* out; const float* gate; float sc;
    __device__ __forceinline__ void operator()(const f32x4 (&acc)[2][2][4][2], const Unit& u, int wr, int wc, int fr, int fq) const {
        const int row0 = u.pm * 256 + wr * 64 + fr, col0 = u.pn * 256 + wc * 32 + fq * 8;
        const int b = (u.pm * 256) >> 12;
#pragma unroll
        for (int bj = 0; bj < 2; ++bj) {
            const int col = col0 + bj * 128;
            const f32x4 g0 = *(const f32x4*)(gate + b * 6144 + col) * sc, g1 = *(const f32x4*)(gate + b * 6144 + col + 4) * sc;
#pragma unroll
            for (int ai = 0; ai < 2; ++ai)
#pragma unroll
                for (int m = 0; m < 4; ++m) {
                    const size_t off = (size_t)(row0 + ai * 128 + m * 16) * D + col;
                    const u32x4 xv = *(const u32x4*)(base + off);
                    const f32x4 x0 = {bf_lo(xv.x), bf_hi(xv.x), bf_lo(xv.y), bf_hi(xv.y)}, x1 = {bf_lo(xv.z), bf_hi(xv.z), bf_lo(xv.w), bf_hi(xv.w)};
                    *(u32x4*)(out + off) = pack8_bf16(x0 + g0 * acc[ai][bj][m][0], x1 + g1 * acc[ai][bj][m][1]);
                }
        }
    }
};

struct EpiSwiglu {
    bf16* O; int ldc;
    __device__ __forceinline__ void operator()(const f32x4 (&acc)[2][2][4][2], const Unit& u, int wr, int wc, int fr, int fq) const {
        const int row0 = u.pm * 256 + wr * 64 + fr, col = u.pn * 128 + wc * 32 + fq * 8;
#pragma unroll
        for (int ai = 0; ai < 2; ++ai)
#pragma unroll
            for (int m = 0; m < 4; ++m) {
                const int row = row0 + ai * 128 + m * 16;
                float r[8];
#pragma unroll
                for (int n = 0; n < 2; ++n)
#pragma unroll
                    for (int e = 0; e < 4; ++e) { const float gt = acc[ai][0][m][n][e], up = acc[ai][1][m][n][e]; r[n * 4 + e] = gt * sigmoidf_(gt) * up; }
                u32x4 w; w.x = cvt_pk_bf16(r[0], r[1]); w.y = cvt_pk_bf16(r[2], r[3]); w.z = cvt_pk_bf16(r[4], r[5]); w.w = cvt_pk_bf16(r[6], r[7]);
                *(u32x4*)(O + (size_t)row * ldc + col) = w;
            }
    }
};

struct EpiSwigluS {
    bf16* O; int ldc;
    __device__ __forceinline__ void operator()(const f32x4 (&acc)[2][2][4][2], const Unit& u, int wr, int wc, int fr, int fq) const {
        const int row0 = u.pm * 256 + wr * 64 + fr, col = u.pn * 128 + wc * 32 + fq * 8;
#pragma unroll
        for (int ai = 0; ai < 2; ++ai)
#pragma unroll
            for (int m = 0; m < 4; ++m) {
                const int row = row0 + ai * 128 + m * 16;
                float r[8];
#pragma unroll
                for (int n = 0; n < 2; ++n)
#pragma unroll
                    for (int e = 0; e < 4; ++e) { const float gt = acc[ai][0][m][n][e] * 0.03125f, up = acc[ai][1][m][n][e] * 0.03125f; r[n * 4 + e] = gt * sigmoidf_(gt) * up; }
                u32x4 w; w.x = cvt_pk_bf16(r[0], r[1]); w.y = cvt_pk_bf16(r[2], r[3]); w.z = cvt_pk_bf16(r[4], r[5]); w.w = cvt_pk_bf16(r[6], r[7]);
                *(u32x4*)(O + (size_t)row * ldc + col) = w;
            }
    }
};

struct EpiSwiglu8 {
    unsigned char* O; int ldc;
    __device__ __forceinline__ void operator()(const f32x4 (&acc)[2][2][4][2], const Unit& u, int wr, int wc, int fr, int fq) const {
        const int row0 = u.pm * 256 + wr * 64 + fr, col = u.pn * 128 + wc * 32 + fq * 8;
#pragma unroll
        for (int ai = 0; ai < 2; ++ai)
#pragma unroll
            for (int m = 0; m < 4; ++m) {
                const int row = row0 + ai * 128 + m * 16;
                float r[8];
#pragma unroll
                for (int n = 0; n < 2; ++n)
#pragma unroll
                    for (int e = 0; e < 4; ++e) { const float gt = acc[ai][0][m][n][e] * 0.03125f, up = acc[ai][1][m][n][e] * 0.03125f; r[n * 4 + e] = gt * sigmoidf_(gt) * up; }
                *(u32x2*)(O + (size_t)row * ldc + col) = (u32x2){cvt_pk4_fp8(r[0], r[1], r[2], r[3]), cvt_pk4_fp8(r[4], r[5], r[6], r[7])};
            }
    }
};

template <bool GATHER_> struct MoeSched {
    static constexpr bool GATHER = GATHER_;
    const LAS int* tab; const int* list; int NT, G, c, nktf;
    __device__ __forceinline__ int expert_of_tile(int pm) const { int e = 0;
#pragma unroll
        for (int j = 1; j < 8; ++j) e += (pm >= tab[8 + j]) ? 1 : 0;
        return e; }
    __device__ bool next(int i, Unit& u) const {
        const int U = tab[16] * NT, xcd = c & 7, off = i * (G >> 3) + (c >> 3), q = U >> 3, r = U & 7;
        if ((G & 7) != 0) { const int L0 = i * G + c; if (L0 >= U) return false; return decode(L0, u); }
        if (off >= q + (xcd < r ? 1 : 0)) return false;
        return decode((xcd < r ? xcd * (q + 1) : r * (q + 1) + (xcd - r) * q) + off, u);
    }
    __device__ __forceinline__ bool decode(int L, Unit& u) const {
        int e = 0;
#pragma unroll
        for (int j = 1; j < 8; ++j) e += (L >= tab[8 + j] * NT) ? 1 : 0;
        const int l = L - tab[8 + e] * NT, Te = tab[9 + e] - tab[8 + e];
        const int nig = 8 * NT, gid = l / nig, fm = gid * 8, gsz = (Te - fm) < 8 ? (Te - fm) : 8, li = l - gid * nig;
        const int pn = li / gsz, pml = fm + (li - pn * gsz);
        u.pm = tab[8 + e] + pml; u.pn = pn; u.pb = e * NT + pn; u.kt0 = 0; u.nkt = nktf; return true;
    }
    __device__ __forceinline__ unsigned arow(const Unit& u, int r) const {
#ifdef DBG_ARITH
        return (unsigned)((u.pm * 256 + r) & 16383);
#endif
        const int e = expert_of_tile(u.pm); const int pos = (u.pm - tab[8 + e]) * 256 + r;
        return pos < tab[e] ? (unsigned)(list[e * 16384 + pos] & 0xffff) : 0u;
    }
};

struct MoeDownSched {
    static constexpr bool GATHER = false;
    const LAS int* tab; int G, c;
    __device__ bool next(int i, Unit& u) const {
        const int L = i * G + c;
        if (L < 512) { u.pn = L >> 7; u.pm = L & 127; u.kt0 = 0; u.nkt = 28; }
        else { const int Lt = L - 512, ntu = (tab[16] - 128) * 4; if (Lt >= ntu * 2) return false;
            const int tu = Lt >> 1; u.pm = 128 + (tu >> 2); u.pn = tu & 3; u.kt0 = (Lt & 1) * 14; u.nkt = 14; }
        int e = 0;
#pragma unroll
        for (int j = 1; j < 8; ++j) e += (u.pm >= tab[8 + j]) ? 1 : 0;
        u.pb = e * 4 + u.pn; return true;
    }
    __device__ __forceinline__ unsigned arow(const Unit&, int) const { return 0u; }
};
struct EpiMoeDown {
    bf16* Y; float* PART; const LAS int* tab; const int* list; const float* lgate;
    __device__ __forceinline__ void operator()(const f32x4 (&acc)[2][2][4][2], const Unit& u, int wr, int wc, int fr, int fq) const {
        int e = 0;
#pragma unroll
        for (int j = 1; j < 8; ++j) e += (u.pm >= tab[8 + j]) ? 1 : 0;
        const int pos0 = (u.pm - tab[8 + e]) * 256 + wr * 64 + fr, cnt = tab[e];
        const int col0 = u.pn * 256 + wc * 32 + fq * 8;
#pragma unroll
        for (int ai = 0; ai < 2; ++ai)
#pragma unroll
            for (int m = 0; m < 4; ++m) {
                const int pos = pos0 + ai * 128 + m * 16;
                if (pos < cnt) {
                    const int ts = list[e * 16384 + pos]; const float gw = lgate[e * 16384 + pos] * 0.03125f;
                    if (u.nkt == 28) {
                        bf16* dst = Y + ((size_t)(ts >> 16) * T + (size_t)(ts & 0xffff)) * D + col0;
#pragma unroll
                        for (int bj = 0; bj < 2; ++bj) { const f32x4 v0 = acc[ai][bj][m][0] * gw, v1 = acc[ai][bj][m][1] * gw;
                            *(u32x4*)(dst + bj * 128) = (u32x4){cvt_pk_bf16(v0[0], v0[1]), cvt_pk_bf16(v0[2], v0[3]), cvt_pk_bf16(v1[0], v1[1]), cvt_pk_bf16(v1[2], v1[3])}; }
                    } else {
                        float* dst = PART + ((size_t)(((u.pm - 128) * 4 + u.pn) * 2 + u.kt0 / 14) * 256 + (size_t)(wr * 64 + fr + ai * 128 + m * 16)) * 256 + wc * 32 + fq * 8;
#pragma unroll
                        for (int bj = 0; bj < 2; ++bj) { *(f32x4*)(dst + bj * 128) = acc[ai][bj][m][0] * gw; *(f32x4*)(dst + bj * 128 + 4) = acc[ai][bj][m][1] * gw; }
                    }
                }
            }
    }
};

__device__ __forceinline__ void transpose_item8(const float* W, int N, int kb, int nb, unsigned char* WT, int ldw, int row_base, LAS float* scr, int lane) {
    const int k0 = 64 * kb, n0 = 32 * nb;
#pragma unroll 8
    for (int i = 0; i < 32; ++i) { const int kk = 2 * i + (lane >> 5); scr[kk * 33 + (lane & 31)] = W[(size_t)(k0 + kk) * N + n0 + (lane & 31)]; }
    LDS_WAIT(); asm volatile("" ::: "memory");
    const int c = lane & 7;
#pragma unroll
    for (int j = 0; j < 4; ++j) { const int n = (lane >> 3) + 8 * j; const LAS float* s = scr + (8 * c) * 33 + n;
        u32x2 o; o.x = cvt_pk4_fp8(s[0 * 33] * 32.f, s[1 * 33] * 32.f, s[2 * 33] * 32.f, s[3 * 33] * 32.f); o.y = cvt_pk4_fp8(s[4 * 33] * 32.f, s[5 * 33] * 32.f, s[6 * 33] * 32.f, s[7 * 33] * 32.f);
        *(u32x2*)(WT + (size_t)(row_base + n) * ldw + k0 + 8 * c) = o; }
    LDS_WAIT(); asm volatile("" ::: "memory");
}
template <bool GUARD>
__device__ __forceinline__ void transpose_item(const float* W, int N, int kb, int nb, bf16* WT, int ldw, int row_base, LAS float* scr, int lane) {
    const int k0 = 64 * kb, n0 = 32 * nb;
#pragma unroll 8
    for (int i = 0; i < 32; ++i) { const int kk = 2 * i + (lane >> 5); const int n = n0 + (lane & 31);
        float v = 0.f; if (!GUARD || n < N) v = W[(size_t)(k0 + kk) * N + n];
        scr[kk * 33 + (lane & 31)] = v; }
    LDS_WAIT(); asm volatile("" ::: "memory");
    const int c = lane & 7;
#pragma unroll
    for (int j = 0; j < 4; ++j) { const int n = (lane >> 3) + 8 * j; const LAS float* s = scr + (8 * c) * 33 + n;
        u32x4 o; o.x = cvt_pk_bf16(s[0 * 33], s[1 * 33]); o.y = cvt_pk_bf16(s[2 * 33], s[3 * 33]); o.z = cvt_pk_bf16(s[4 * 33], s[5 * 33]); o.w = cvt_pk_bf16(s[6 * 33], s[7 * 33]);
        *(u32x4*)(WT + (size_t)(row_base + n) * ldw + k0 + 8 * c) = o; }
    LDS_WAIT(); asm volatile("" ::: "memory");
}
__device__ __forceinline__ int ilv_row(int n0, int up) { return (n0 >> 7) * 256 + (n0 & 127) + up * 128; }

__device__ __forceinline__ float rope_inv(int j) {
    return j == 0 ? 1.0f : j == 1 ? 0.1939227432012558f : j == 2 ? 0.03760603070259094f : j == 3 ? 0.007292664609849453f :
           j == 4 ? 0.0014142135623842478f : j == 5 ? 0.00027424818836152554f : j == 6 ? 5.3182957344688475e-05f : 1.0313385246263351e-05f;
}

__device__ __forceinline__ void p0_prologue(const Ctx& F, const Args& a) {
    unsigned char* ws = F.ws;
    LAS float* scr = (LAS float*)(F.lds + F.wave * 16384);
    constexpr int C1 = 16 * 64, C2 = 16 * 32, C3 = 8 * 16, C4 = 16 * 88, C6 = 44 * 32, C7 = 16 * 59, CM = 16 * 112, CD = 56 * 32;
    constexpr int NITEMS = C1 + C2 + C3 + 2 * C4 + C6 + C7 + C2 + 8 * (2 * CM + CD);
    for (int it = F.gw; it < NITEMS; it += F.NGW) {
        int r = it;
        if (r < C1) { transpose_item<false>(a.in[I_EWIN], 2048, r / 64, r % 64, (bf16*)(ws + WS_WIN0), 1024, 32 * (r % 64), scr, F.lane); continue; } r -= C1;
        if (r < C2) { transpose_item<false>(a.in[I_EWOUT], 1024, r / 32, r % 32, (bf16*)(ws + WS_WOUT0), 1024, 32 * (r % 32), scr, F.lane); continue; } r -= C2;
        if (r < C3) { transpose_item<false>(a.in[I_WGLU], 512, r / 16, r % 16, (bf16*)(ws + WS_WGLU), 512, 32 * (r % 16), scr, F.lane); continue; } r -= C3;
        if (r < C4) { transpose_item8(a.in[I_FFG], FFD, r / 88, r % 88, ws + WS_WGU0, 1024, ilv_row(32 * (r % 88), 0), scr, F.lane); continue; } r -= C4;
        if (r < C4) { transpose_item8(a.in[I_FFU], FFD, r / 88, r % 88, ws + WS_WGU0, 1024, ilv_row(32 * (r % 88), 1), scr, F.lane); continue; } r -= C4;
        if (r < C6) { transpose_item8(a.in[I_FFD], 1024, r / 32, r % 32, ws + WS_WDN0, FFD, 32 * (r % 32), scr, F.lane); continue; } r -= C6;
        if (r < C7) { transpose_item<true>(a.in[I_OWIN], CIN, r / 59, r % 59, (bf16*)(ws + WS_WIN1), 1024, 32 * (r % 59), scr, F.lane); continue; } r -= C7;
        if (r < C2) { transpose_item<false>(a.in[I_OWOUT], 1024, r / 32, r % 32, (bf16*)(ws + WS_WOUT1), 1024, 32 * (r % 32), scr, F.lane); continue; } r -= C2;
        const int e = r / (2 * CM + CD); r -= e * (2 * CM + CD);
        if (r < CM) { transpose_item8(a.in[I_MG] + (size_t)e * 1024 * FFE, FFE, r / 112, r % 112, ws + WS_WMGU + (size_t)e * 7168 * 1024, 1024, ilv_row(32 * (r % 112), 0), scr, F.lane); continue; } r -= CM;
        if (r < CM) { transpose_item8(a.in[I_MU] + (size_t)e * 1024 * FFE, FFE, r / 112, r % 112, ws + WS_WMGU + (size_t)e * 7168 * 1024, 1024, ilv_row(32 * (r % 112), 1), scr, F.lane); continue; } r -= CM;
        transpose_item8(a.in[I_MD] + (size_t)e * FFE * 1024, 1024, r / 32, r % 32, ws + WS_WMDN + (size_t)e * 1024 * FFE, FFE, 32 * (r % 32), scr, F.lane);
    }
    const int gtid = F.vcu * NTHR + F.tid, NGT = F.G * NTHR;
    for (int i = gtid; i < 160 * 128; i += NGT) *(u32x4*)(ws + WS_WIN1 + (size_t)1888 * 2048 + (size_t)i * 16) = (u32x4){0u, 0u, 0u, 0u};
    for (int it = F.gw; it < 768; it += F.NGW) {
        const int layer = it / 384, r = it % 384, kc = r / 24, jc = r % 24;
        const int j = jc * 256 + F.lane * 4;
        float cv[4];
#pragma unroll
        for (int b = 0; b < 4; ++b) { const float x = a.in[I_C][b * 1024 + kc * 64 + F.lane]; cv[b] = x * sigmoidf_(x); }
        f32x4 acc[4] = {{0.f, 0.f, 0.f, 0.f}, {0.f, 0.f, 0.f, 0.f}, {0.f, 0.f, 0.f, 0.f}, {0.f, 0.f, 0.f, 0.f}};
        const float* wp = a.in[I_WADA] + ((size_t)layer * 1024 + kc * 64) * 6144 + j;
#pragma unroll 8
        for (int k = 0; k < 64; ++k) { const f32x4 w = *(const f32x4*)(wp + (size_t)k * 6144);
#pragma unroll
            for (int b = 0; b < 4; ++b) { const float s = __shfl(cv[b], k); acc[b] += w * s; } }
#pragma unroll
        for (int b = 0; b < 4; ++b) *(f32x4*)((float*)(ws + WS_MODP) + ((size_t)(kc * 2 + layer) * 4 + b) * 6144 + j) = acc[b];
    }
    for (int i = gtid; i < SEQ * 8; i += NGT) { const int pos = i >> 3, j = i & 7; const float ang = (float)pos * rope_inv(j);
        float* cs = (float*)(ws + WS_ROPE) + pos * 16; cs[j] = cosf(ang); cs[8 + j] = sinf(ang); }
    for (int i = gtid; i < 32 * 64; i += NGT) {
        const int g = i >> 6;
        const float dt = expf(a.in[I_LOGDT][g]), lr = a.in[I_ARE][i], li = a.in[I_AIM][i];
        const float mag = expf(lr * dt), ar = mag * cosf(li * dt), ai = mag * sinf(li * dt);
        const float den = lr * lr + li * li, nr = ar - 1.0f, fr = (nr * lr + ai * li) / den, fi = (ai * lr - nr * li) / den;
        float pr = ar, pi = ai;
#pragma unroll
        for (int s = 0; s < 8; ++s) { const float tr = pr * pr - pi * pi, ti = 2.f * pr * pi; pr = tr; pi = ti; }
        *(f32x4*)((float*)(ws + WS_ABAR) + i * 4) = (f32x4){ar, ai, pr, pi};
        bf16* bbr = (bf16*)(ws + WS_BBAR) + ((size_t)g * 128 + (i & 63)) * 16; bf16* bbi = bbr + 64 * 16;
#pragma unroll
        for (int c = 0; c < 16; ++c) { const float br = a.in[I_BRE][i * 16 + c], bi = a.in[I_BIM][i * 16 + c]; bbr[c] = f2bf(fr * br - fi * bi); bbi[c] = f2bf(fr * bi + fi * br); }
    }
    for (int i = gtid; i < 32 * 16 * 128; i += NGT) { const int gc = i >> 7, k = i & 127;
        const float v = (k < 64) ? a.in[I_CRE][gc * 64 + k] : -a.in[I_CIM][gc * 64 + (k - 64)];
        ((bf16*)(ws + WS_CMAT))[i] = f2bf(v); }
    for (int i = gtid; i < 16 * 256 * 64; i += NGT) { const int n = i & 63, c = (i >> 6) & 255, h = i >> 14;
        ((bf16*)(ws + WS_WUK))[i] = f2bf(n < 48 ? a.in[I_WUK][(c * 16 + h) * 48 + n] : 0.f); }
    for (int i = gtid; i < 16 * 64 * 256; i += NGT) { const int c = i & 255, d = (i >> 8) & 63, h = i >> 14;
        ((bf16*)(ws + WS_WUV))[i] = f2bf(a.in[I_WUV][(c * 16 + h) * 64 + d]); }
}

__device__ __forceinline__ f32x4 modp4(const Args& a, const unsigned char* ws, int layer, int b, int j) {
    f32x4 s = *(const f32x4*)(a.in[I_BADA] + layer * 6144 + j);
#pragma unroll
    for (int kc = 0; kc < 16; ++kc) s += *(const f32x4*)((const float*)(ws + WS_MODP) + ((size_t)(kc * 2 + layer) * 4 + b) * 6144 + j);
    return s;
}
template <bool FROMP, bool ROUTER, bool F8 = ROUTER, bool HB = true>
__device__ __forceinline__ void norm_phase(const Ctx& F, const Args& a, const void* h, const float* g, int layer, int sh_off, int sc_off) {
    unsigned char* ws = F.ws;
    const int row0 = F.gw * 8, b = row0 >> 12;
    f32x4 gs[4], sh[4];
#pragma unroll
    for (int j = 0; j < 4; ++j) { const int col = 4 * F.lane + 256 * j;
        f32x4 sc;
        if (FROMP) { sc = modp4(a, ws, layer, b, sc_off + col); sh[j] = modp4(a, ws, layer, b, sh_off + col); }
        else { const float* mf = (const float*)(ws + WS_MODF) + (size_t)(layer * 4 + b) * 6144; sc = *(const f32x4*)(mf + sc_off + col); sh[j] = *(const f32x4*)(mf + sh_off + col); }
        gs[j] = *(const f32x4*)(g + col) * (sc + 1.0f); }
    float wr[ROUTER ? 16 : 1][ROUTER ? 8 : 1]; float br[8];
    if (ROUTER) {
#pragma unroll
        for (int j = 0; j < 4; ++j)
#pragma unroll
            for (int e4 = 0; e4 < 4; ++e4) { const float* p = a.in[I_ROUTER] + (size_t)(4 * F.lane + 256 * j + e4) * 8; const f32x4 w0 = *(const f32x4*)p, w1 = *(const f32x4*)(p + 4);
#pragma unroll
                for (int e = 0; e < 4; ++e) { wr[j * 4 + e4][e] = w0[e]; wr[j * 4 + e4][4 + e] = w1[e]; } }
#pragma unroll
        for (int e = 0; e < 8; ++e) br[e] = a.in[I_BROUTER][e];
    }
    for (int r = 0; r < 8; ++r) {
        const int row = row0 + r;
        f32x4 v[4]; float s = 0.f;
#pragma unroll
        for (int j = 0; j < 4; ++j) {
            if (HB) { const u32x2 t = ((const u32x2*)((const bf16*)h + (size_t)row * D) + F.lane)[64 * j]; v[j] = (f32x4){bf_lo(t.x), bf_hi(t.x), bf_lo(t.y), bf_hi(t.y)}; }
            else v[j] = ((const f32x4*)((const float*)h + (size_t)row * D) + F.lane)[64 * j];
            s += (v[j].x * v[j].x + v[j].y * v[j].y) + (v[j].z * v[j].z + v[j].w * v[j].w); }
        const float rstd = 1.0f / sqrtf(wave_sum(s) * (1.f / D) + NORM_EPS);
        unsigned long long* o8 = (unsigned long long*)((bf16*)(ws + WS_U) + (size_t)row * D) + F.lane;
        unsigned* o4 = (unsigned*)(ws + WS_U8 + (size_t)row * D) + F.lane;
#pragma unroll
        for (int j = 0; j < 4; ++j) { v[j] = v[j] * rstd * gs[j] + sh[j];
            if (F8) o4[64 * j] = cvt_pk4_fp8(v[j].x, v[j].y, v[j].z, v[j].w);
            else o8[64 * j] = (unsigned long long)cvt_pk_bf16(v[j].x, v[j].y) | ((unsigned long long)cvt_pk_bf16(v[j].z, v[j].w) << 32); }
        if (ROUTER) {
            float lg[8];
#pragma unroll
            for (int e = 0; e < 8; ++e) { float t = 0.f;
#pragma unroll
                for (int j = 0; j < 4; ++j)
#pragma unroll
                    for (int e4 = 0; e4 < 4; ++e4) t += v[j][e4] * wr[j * 4 + e4][e];
                lg[e] = wave_sum(t) + br[e]; }
            if (F.lane == 0) {
                int e0 = 0; float v0 = lg[0];
#pragma unroll
                for (int e = 1; e < 8; ++e) if (lg[e] > v0) { v0 = lg[e]; e0 = e; }
                int e1 = -1; float v1 = -3.0e38f;
#pragma unroll
                for (int e = 0; e < 8; ++e) if (e != e0 && lg[e] > v1) { v1 = lg[e]; e1 = e; }
                const float g0 = 1.0f / (1.0f + expf(v1 - v0)), g1 = 1.0f - g0;
                unsigned* cnt = (unsigned*)(ws + WS_CTL) + CW_CNT;
                const unsigned p0 = __hip_atomic_fetch_add(cnt + e0, 1u, RLX_AGENT), p1 = __hip_atomic_fetch_add(cnt + e1, 1u, RLX_AGENT);
                ((int*)(ws + WS_LIST))[e0 * 16384 + p0] = row; ((float*)(ws + WS_LGATE))[e0 * 16384 + p0] = g0;
                ((int*)(ws + WS_LIST))[e1 * 16384 + p1] = row | (1 << 16); ((float*)(ws + WS_LGATE))[e1 * 16384 + p1] = g1;
                ((int*)(ws + WS_KI))[row * 2] = e0 * 16384 + (int)p0; ((int*)(ws + WS_KI))[row * 2 + 1] = e1 * 16384 + (int)p1;
            }
        }
    }
}
__device__ __forceinline__ void modf_finalize(const Ctx& F, const Args& a) {
    const int gtid = F.vcu * NTHR + F.tid, NGT = F.G * NTHR;
    for (int i = gtid; i < 2 * 4 * 1536; i += NGT) { const int j = (i % 1536) * 4, lb = i / 1536;
        *(f32x4*)((float*)(F.ws + WS_MODF) + (size_t)lb * 6144 + j) = modp4(a, F.ws, lb >> 2, lb & 3, j); }
}
__device__ __forceinline__ f32x4 moe_slot4(const unsigned char* ws, const LAS int* tab, int row, int slot, int j, int lane) {
    const int ep = ((const int*)(ws + WS_KI))[row * 2 + slot]; const int e = ep >> 14, pos = ep & 16383;
    const int srow = tab[8 + e] * 256 + pos, pm = srow >> 8;
    if (pm < 128) { const u32x2 v = *((const u32x2*)((const bf16*)(ws + WS_YSLOT) + ((size_t)slot * T + row) * D) + lane + 64 * j); return (f32x4){bf_lo(v.x), bf_hi(v.x), bf_lo(v.y), bf_hi(v.y)}; }
    const float* p = (const float*)(ws + WS_PART) + ((size_t)(((pm - 128) * 4 + j) * 2) * 256 + (srow & 255)) * 256 + 4 * lane;
    return *(const f32x4*)p + *(const f32x4*)(p + 65536);
}
__device__ __forceinline__ void final_phase(const Ctx& F, const Args& a) {
    const int row0 = F.gw * 8, b = row0 >> 12;
    const float* mf = (const float*)(F.ws + WS_MODF) + (size_t)(4 + b) * 6144 + 5120;
    const LAS int* tab = (const LAS int*)(F.lds + MISC_OFF + 64);
    f32x4 gt[4], gf[4];
#pragma unroll
    for (int j = 0; j < 4; ++j) { gt[j] = *(const f32x4*)(mf + 4 * F.lane + 256 * j); gf[j] = *(const f32x4*)(a.in[I_GFINAL] + 4 * F.lane + 256 * j); }
    for (int r = 0; r < 8; ++r) {
        const int row = row0 + r;
        f32x4* xr = (f32x4*)(a.out + (size_t)row * D) + F.lane;
        const u32x2* hr = (const u32x2*)((const bf16*)(F.ws + WS_H) + (size_t)row * D) + F.lane;
        f32x4 v[4]; float s = 0.f;
#ifndef DBG_NOMOE
#define DBG_NOMOE 1.0f
#endif
#pragma unroll
        for (int j = 0; j < 4; ++j) { const u32x2 t = hr[64 * j]; v[j] = (f32x4){bf_lo(t.x), bf_hi(t.x), bf_lo(t.y), bf_hi(t.y)} + gt[j] * ((moe_slot4(F.ws, tab, row, 0, j, F.lane) + moe_slot4(F.ws, tab, row, 1, j, F.lane)) * DBG_NOMOE); s += (v[j].x * v[j].x + v[j].y * v[j].y) + (v[j].z * v[j].z + v[j].w * v[j].w); }
        const float rstd = 1.0f / sqrtf(wave_sum(s) * (1.f / D) + NORM_EPS);
#pragma unroll
        for (int j = 0; j < 4; ++j) xr[64 * j] = v[j] * rstd * gf[j];
    }
}

__device__ __forceinline__ bf16x8 ld_bf16x8(const bf16* p) { return *(const bf16x8*)p; }
#define TRRD(dst, addr, off) asm volatile("ds_read_b64_tr_b16 %0, %1 offset:%c2" : "=&v"(dst) : "v"(addr), "i"(off) : "memory")

constexpr int S5_LDS = 14336;
template <bool PASS2>
__device__ __forceinline__ void s5_unit(const Ctx& F, const Args& a, int b, int g, int sc, LAS unsigned char* wl) {
    const unsigned char* ws = F.ws;
    const int lane = F.lane, fr = lane & 15, g4 = lane >> 4;
    const f32x4 ab = *(const f32x4*)((const float*)(ws + WS_ABAR) + (g * 64 + lane) * 4);
    const float ar = ab.x, ai = ab.y;
    bf16x8 bt[8];
#pragma unroll
    for (int nt = 0; nt < 8; ++nt) { bt[nt] = (bf16x8){0, 0, 0, 0, 0, 0, 0, 0};
        if (g4 < 2) bt[nt] = ld_bf16x8((const bf16*)(ws + WS_BBAR) + ((size_t)g * 128 + 16 * nt + fr) * 16 + 8 * g4); }
    float xr = 0.f, xi = 0.f;
    bf16x8 cm[4]; float dsk[4];
    if (PASS2) {
        const f32x2* xe = (const f32x2*)(ws + WS_XEND) + (size_t)((b * 32 + g) * 16) * 64 + lane;
        for (int j = 0; j < sc; ++j) { const f32x2 e = xe[j * 64]; const float nr = xr * ab.z - xi * ab.w + e.x, ni = xr * ab.w + xi * ab.z + e.y; xr = nr; xi = ni; }
#pragma unroll
        for (int ks = 0; ks < 4; ++ks) cm[ks] = ld_bf16x8((const bf16*)(ws + WS_CMAT) + (size_t)(g * 16 + fr) * 128 + 32 * ks + 8 * g4);
#pragma unroll
        for (int e = 0; e < 4; ++e) dsk[e] = a.in[I_SD][g * 16 + 4 * g4 + e];
    }
    LAS float* buL = (LAS float*)wl;
    LAS bf16* xL = (LAS bf16*)(wl + 8448);
    LAS float* uL = (LAS float*)(wl + 8448 + 4352);
    const bf16* up = (const bf16*)(ws + WS_PROJ) + ((size_t)(b * SEQ + sc * 256 + fr)) * 2048 + 1536 + g * 16 + 8 * (g4 & 1);
    bf16x8 unext = ld_bf16x8(up);
    for (int tb = 0; tb < 16; ++tb) {
        bf16x8 uc = unext;
        if (tb < 15) unext = ld_bf16x8(up + (size_t)(tb + 1) * 16 * 2048);
        if (g4 >= 2) uc = (bf16x8){0, 0, 0, 0, 0, 0, 0, 0};
        if (PASS2 && g4 < 2) { const u32x4 w = __builtin_bit_cast(u32x4, uc);
            *(LAS f32x4*)(uL + fr * 16 + 8 * g4) = (f32x4){bf_lo(w.x), bf_hi(w.x), bf_lo(w.y), bf_hi(w.y)}; *(LAS f32x4*)(uL + fr * 16 + 8 * g4 + 4) = (f32x4){bf_lo(w.z), bf_hi(w.z), bf_lo(w.w), bf_hi(w.w)}; }
#pragma unroll
        for (int nt = 0; nt < 8; ++nt) { const f32x4 z = {0.f, 0.f, 0.f, 0.f};
            const f32x4 c = __builtin_amdgcn_mfma_f32_16x16x32_bf16(uc, bt[nt], z, 0, 0, 0);
#pragma unroll
            for (int e = 0; e < 4; ++e) buL[(4 * g4 + e) * 132 + 16 * nt + fr] = c[e] + 0.0f; }
        asm volatile("" :: "v"(uc));
        LDS_WAIT(); asm volatile("" ::: "memory");
#pragma unroll 4
        for (int tl = 0; tl < 16; ++tl) {
            const float bur = buL[tl * 132 + lane], bui = buL[tl * 132 + 64 + lane];
            const float nr = ar * xr - ai * xi + bur, ni = ar * xi + ai * xr + bui; xr = nr; xi = ni;
            if (PASS2) { xL[tl * 136 + lane] = f2bf(xr); xL[tl * 136 + 64 + lane] = f2bf(xi); }
        }
        if (PASS2) {
            LDS_WAIT(); asm volatile("" ::: "memory");
            f32x4 acc = {0.f, 0.f, 0.f, 0.f};
#pragma unroll
            for (int ks = 0; ks < 4; ++ks) { const bf16x8 xb = *(const LAS bf16x8*)(xL + fr * 136 + 32 * ks + 8 * g4);
                acc = __builtin_amdgcn_mfma_f32_16x16x32_bf16(cm[ks], xb, acc, 0, 0, 0); }
            const f32x4 u4 = *(const LAS f32x4*)(uL + fr * 16 + 4 * g4);
            float y[4];
#pragma unroll
            for (int e = 0; e < 4; ++e) { const float v = acc[e] + dsk[e] * u4[e]; const float z = 1.5957691216057308f * (v + 0.044715f * v * v * v); y[e] = v * sigmoidf_(z); }
            bf16* yo = (bf16*)(ws + WS_YG) + (size_t)(b * SEQ + sc * 256 + tb * 16 + fr) * 512 + g * 16 + 4 * g4;
            *(u32x2*)yo = (u32x2){cvt_pk_bf16(y[0], y[1]), cvt_pk_bf16(y[2], y[3])};
        }
        LDS_WAIT(); asm volatile("" ::: "memory");
    }
    if (!PASS2) ((f32x2*)(ws + WS_XEND))[(size_t)((b * 32 + g) * 16 + sc) * 64 + lane] = (f32x2){xr, xi};
}

struct DilKV { bf16x8 ka[2], kb[2]; u32x4 vv[4]; };
template <int DST>
__device__ __forceinline__ void dil_load(DilKV& f, const bf16* Kb, const bf16* Vb, int t0r, int m0, int lane) {
    const int fr = lane & 15, g = lane >> 4;
    int pa = t0r + DST * (m0 + fr), pb = pa + DST * 16;
    pa = pa < 0 ? 0 : (pa > SEQ - 1 ? SEQ - 1 : pa); pb = pb < 0 ? 0 : (pb > SEQ - 1 ? SEQ - 1 : pb);
#pragma unroll
    for (int ks = 0; ks < 2; ++ks) { f.ka[ks] = ld_bf16x8(Kb + (size_t)pa * 2048 + 32 * ks + 8 * g); f.kb[ks] = ld_bf16x8(Kb + (size_t)pb * 2048 + 32 * ks + 8 * g); }
#pragma unroll
    for (int j = 0; j < 4; ++j) { int pv = t0r + DST * (m0 + (lane >> 3) + 8 * j); pv = pv < 0 ? 0 : (pv > SEQ - 1 ? SEQ - 1 : pv);
        f.vv[j] = *(const u32x4*)(Vb + (size_t)pv * 2048 + 8 * (lane & 7)); }
}
template <int DST>
__device__ __forceinline__ void dil_step(const DilKV& f, int t0r, int m0, const bf16x8 (&qf)[2], float& mrun, float& lsum, f32x4 (&o)[4], LAS unsigned char* vl, unsigned vaddr, int lane) {
    const int fr = lane & 15, g = lane >> 4;
    const int qm = (16 / DST) * fr;
    f32x4 sa = {0.f, 0.f, 0.f, 0.f}, sb = sa;
#pragma unroll
    for (int ks = 0; ks < 2; ++ks) { sa = __builtin_amdgcn_mfma_f32_16x16x32_bf16(f.ka[ks], qf[ks], sa, 0, 0, 0); sb = __builtin_amdgcn_mfma_f32_16x16x32_bf16(f.kb[ks], qf[ks], sb, 0, 0, 0); }
#pragma unroll
    for (int j = 0; j < 4; ++j) *(LAS u32x4*)(vl + ((lane >> 3) + 8 * j) * 160 + (lane & 7) * 16) = f.vv[j];
    float cmax = -INFINITY;
    const int mlo = (qm - 128) > -(t0r / DST) ? (qm - 128) : -(t0r / DST);
    const unsigned span = (unsigned)(qm - mlo); const int mb0 = m0 + 4 * g - mlo;
#pragma unroll
    for (int e = 0; e < 4; ++e) {
        const bool va = (unsigned)(mb0 + e) <= span, vb = (unsigned)(mb0 + 16 + e) <= span;
        sa[e] = va ? sa[e] : -INFINITY; sb[e] = vb ? sb[e] : -INFINITY;
        cmax = fmaxf(cmax, fmaxf(sa[e], sb[e]));
    }
    cmax = fmaxf(cmax, __shfl_xor(cmax, 16)); cmax = fmaxf(cmax, __shfl_xor(cmax, 32));
    if (__any(cmax > mrun + 64.0f)) {
        const float mnew = fmaxf(mrun, cmax), alpha = __builtin_amdgcn_exp2f((mrun - mnew) * 0.18033688011f);
        mrun = mnew; lsum *= alpha;
#pragma unroll
        for (int dt = 0; dt < 4; ++dt) o[dt] *= alpha;
    }
    const float mneg = -mrun * 0.18033688011f;
    float ps = 0.f;
#pragma unroll
    for (int e = 0; e < 4; ++e) { sa[e] = __builtin_amdgcn_exp2f(__builtin_fmaf(sa[e], 0.18033688011f, mneg)); sb[e] = __builtin_amdgcn_exp2f(__builtin_fmaf(sb[e], 0.18033688011f, mneg)); ps += sa[e] + sb[e]; }
    lsum += ps;
    bf16x8 pf;
    { const u32x4 pk = {cvt_pk_bf16(sa[0], sa[1]), cvt_pk_bf16(sa[2], sa[3]), cvt_pk_bf16(sb[0], sb[1]), cvt_pk_bf16(sb[2], sb[3])}; pf = __builtin_bit_cast(bf16x8, pk); }
    s16x4 lo[4], hi[4];
#pragma unroll
    for (int dt = 0; dt < 4; ++dt) { TRRD(lo[dt], vaddr, dt * 32); TRRD(hi[dt], vaddr, 16 * 160 + dt * 32); }
    asm volatile("s_waitcnt lgkmcnt(0)" ::: "memory"); SBAR();
#pragma unroll
    for (int dt = 0; dt < 4; ++dt) { const bf16x8 vf = {lo[dt][0], lo[dt][1], lo[dt][2], lo[dt][3], hi[dt][0], hi[dt][1], hi[dt][2], hi[dt][3]};
        o[dt] = __builtin_amdgcn_mfma_f32_16x16x32_bf16(vf, pf, o[dt], 0, 0, 0); }
}
template <int DST, int MLO, int NSTEP>
__device__ __forceinline__ void dil_branch(const bf16* Kb, const bf16* Vb, int t0r, const bf16x8 (&qf)[2], float& mrun, float& lsum, f32x4 (&o)[4], LAS unsigned char* vl, int lane) {
    const int fr = lane & 15, g = lane >> 4;
    const unsigned vaddr = (unsigned)(uintptr_t)vl + (unsigned)((4 * g + (fr >> 2)) * 160 + (fr & 3) * 8);
    DilKV f0, f1;
    dil_load<DST>(f0, Kb, Vb, t0r, MLO, lane);
#pragma unroll 1
    for (int s = 0; s < NSTEP; s += 2) {
        if (s + 1 < NSTEP) dil_load<DST>(f1, Kb, Vb, t0r, MLO + 32 * (s + 1), lane);
        dil_step<DST>(f0, t0r, MLO + 32 * s, qf, mrun, lsum, o, vl, vaddr, lane);
        if (s + 1 < NSTEP) {
            if (s + 2 < NSTEP) dil_load<DST>(f0, Kb, Vb, t0r, MLO + 32 * (s + 2), lane);
            dil_step<DST>(f1, t0r, MLO + 32 * (s + 1), qf, mrun, lsum, o, vl, vaddr, lane);
        }
    }
}
__device__ __forceinline__ void dil_unit(const Ctx& F, int b, int head, int blk, int r, LAS unsigned char* vl  ) {
    const unsigned char* ws = F.ws; const int lane = F.lane, fr = lane & 15, g = lane >> 4;
    const bf16* P = (const bf16*)(ws + WS_PROJ) + (size_t)b * SEQ * 2048 + head * 64;
    const int t0r = blk * 256 + r;
    bf16x8 qf[2];
#pragma unroll
    for (int ks = 0; ks < 2; ++ks) qf[ks] = ld_bf16x8(P + (size_t)(t0r + 16 * fr) * 2048 + 32 * ks + 8 * g);
    float mrun = -1.0e30f, lsum = 0.f;
    f32x4 o[4] = {{0.f, 0.f, 0.f, 0.f}, {0.f, 0.f, 0.f, 0.f}, {0.f, 0.f, 0.f, 0.f}, {0.f, 0.f, 0.f, 0.f}};
    dil_branch<16, -144, 5>(P + 512, P + 1024, t0r, qf, mrun, lsum, o, vl, lane);
    dil_branch<4, -128, 6>(P + 512, P + 1024, t0r, qf, mrun, lsum, o, vl, lane);
    dil_branch<1, -128, 12>(P + 512, P + 1024, t0r, qf, mrun, lsum, o, vl, lane);
    lsum += __shfl_xor(lsum, 16); lsum += __shfl_xor(lsum, 32);
    const float inv = 1.0f / lsum;
    bf16* O = (bf16*)(ws + WS_CAT) + (size_t)(b * SEQ + t0r + 16 * fr) * 1024 + head * 64 + 4 * g;
#pragma unroll
    for (int dt = 0; dt < 4; ++dt) *(u32x2*)(O + 16 * dt) = (u32x2){cvt_pk_bf16(o[dt][0] * inv, o[dt][1] * inv), cvt_pk_bf16(o[dt][2] * inv, o[dt][3] * inv)};
}

__device__ __forceinline__ void prep1_token(const Ctx& F, const Args& a, int row) {
    unsigned char* ws = F.ws; const int lane = F.lane;
    const bf16* pr = (const bf16*)(ws + WS_PROJ) + (size_t)row * 2048;
    const float* cs = (const float*)(ws + WS_ROPE) + (size_t)(row & (SEQ - 1)) * 16;
    const f32x4 c0 = *(const f32x4*)cs, c1 = *(const f32x4*)(cs + 4), s0 = *(const f32x4*)(cs + 8), s1 = *(const f32x4*)(cs + 12);
    { const u32x2 v = *(const u32x2*)(pr + 1024 + 4 * lane);
      float x[4] = {bf_lo(v.x), bf_hi(v.x), bf_lo(v.y), bf_hi(v.y)};
      const float ss = wave_sum(x[0] * x[0] + x[1] * x[1] + x[2] * x[2] + x[3] * x[3]);
      const float rstd = 1.0f / sqrtf(ss * (1.f / 256.f) + NORM_EPS);
      const f32x4 gk = *(const f32x4*)(a.in[I_GKV] + 4 * lane);
      *(u32x2*)((bf16*)(ws + WS_KOP) + (size_t)row * 272 + 4 * lane) = (u32x2){cvt_pk_bf16(x[0] * rstd * gk.x, x[1] * rstd * gk.y), cvt_pk_bf16(x[2] * rstd * gk.z, x[3] * rstd * gk.w)}; }
#define ROPE8(v, isx2) do { float _o[8]; _Pragma("unroll") for (int _e = 0; _e < 8; ++_e) _o[_e] = __shfl_xor(v[_e], 1); \
        _Pragma("unroll") for (int _e = 0; _e < 8; ++_e) { const float _c = _e < 4 ? c0[_e & 3] : c1[_e & 3], _s = _e < 4 ? s0[_e & 3] : s1[_e & 3]; \
            v[_e] = (isx2) ? v[_e] * _c + _o[_e] * _s : v[_e] * _c - _o[_e] * _s; } } while (0)
#define UNPK8(W_, v) do { v[0] = bf_lo(W_[0]); v[1] = bf_hi(W_[0]); v[2] = bf_lo(W_[1]); v[3] = bf_hi(W_[1]); v[4] = bf_lo(W_[2]); v[5] = bf_hi(W_[2]); v[6] = bf_lo(W_[3]); v[7] = bf_hi(W_[3]); } while (0)
#define PK8(v) ((u32x4){cvt_pk_bf16(v[0], v[1]), cvt_pk_bf16(v[2], v[3]), cvt_pk_bf16(v[4], v[5]), cvt_pk_bf16(v[6], v[7])})
    { const int l = lane & 31; const bool iskr = lane >= 32;
      const bf16* src = iskr ? pr + 1280 + 8 * (lane & 1) : pr + 8 * l;
      const u32x4 w = *(const u32x4*)src; float v[8]; UNPK8(w, v);
      ROPE8(v, (lane & 1));
      if (!iskr) *(u32x4*)((bf16*)(ws + WS_QOP) + ((size_t)row * 16 + (l >> 1)) * 272 + 256 + 8 * (l & 1)) = PK8(v);
      else if (lane < 34) *(u32x4*)((bf16*)(ws + WS_KOP) + (size_t)row * 272 + 256 + 8 * (lane & 1)) = PK8(v); }
    { const u32x4 w = *(const u32x4*)(pr + 1296 + 8 * lane); float v[8]; UNPK8(w, v); float r[8];
#pragma unroll
      for (int e = 0; e < 8; ++e) r[e] = v[e];
      ROPE8(r, (lane & 1));
      const bool rp = (lane & 7) < 2;
#pragma unroll
      for (int e = 0; e < 8; ++e) v[e] = rp ? r[e] : v[e];
      *(u32x4*)((bf16*)(ws + WS_QI) + (size_t)row * 512 + 8 * lane) = PK8(v); }
    { const u32x4 w = *(const u32x4*)(pr + 1808 + 8 * (lane & 7)); float v[8]; UNPK8(w, v); float r[8];
#pragma unroll
      for (int e = 0; e < 8; ++e) r[e] = v[e];
      ROPE8(r, (lane & 1));
      const bool rp = (lane & 7) < 2;
#pragma unroll
      for (int e = 0; e < 8; ++e) v[e] = rp ? r[e] : v[e];
      if (lane < 8) *(u32x4*)((bf16*)(ws + WS_KI) + (size_t)row * 64 + 8 * lane) = PK8(v);
      if (lane == 8) { const u32x4 ww = *(const u32x4*)(pr + 1872); float t[8]; UNPK8(ww, t); const float sc = 0.35355339059327373f * 0.125f;
          float* wo = (float*)(ws + WS_WI) + (size_t)row * 8; *(f32x4*)wo = (f32x4){t[0] * sc, t[1] * sc, t[2] * sc, t[3] * sc}; *(f32x4*)(wo + 4) = (f32x4){t[4] * sc, t[5] * sc, t[6] * sc, t[7] * sc}; } }
}
__device__ __forceinline__ void qlat_wave(const Ctx& F) {
    unsigned char* ws = F.ws; const int lane = F.lane, fr = lane & 15, g = lane >> 4;
    for (int wq = F.gw; wq < 2048; wq += F.NGW) {
        const int h = wq & 15;
        bf16x8 af[16][2];
#pragma unroll
        for (int ct = 0; ct < 16; ++ct)
#pragma unroll
            for (int ks = 0; ks < 2; ++ks) af[ct][ks] = ld_bf16x8((const bf16*)(ws + WS_WUK) + ((size_t)h * 256 + 16 * ct + fr) * 64 + 32 * ks + 8 * g);
        for (int tt = (wq >> 4); tt < 1024; tt += 128) {
            const bf16* qn = (const bf16*)(ws + WS_PROJ) + (size_t)(16 * tt + fr) * 2048 + 256 + 48 * h + 8 * g;
            const bf16x8 b0 = ld_bf16x8(qn);
            bf16x8 b1 = {0, 0, 0, 0, 0, 0, 0, 0};
            if (g < 2) b1 = ld_bf16x8(qn + 32);
            bf16* qo = (bf16*)(ws + WS_QOP) + ((size_t)(16 * tt + fr) * 16 + h) * 272 + 4 * g;
#pragma unroll
            for (int ct = 0; ct < 16; ++ct) {
                f32x4 acc = {0.f, 0.f, 0.f, 0.f};
                acc = __builtin_amdgcn_mfma_f32_16x16x32_bf16(af[ct][0], b0, acc, 0, 0, 0);
                acc = __builtin_amdgcn_mfma_f32_16x16x32_bf16(af[ct][1], b1, acc, 0, 0, 0);
                *(u32x2*)(qo + 16 * ct) = (u32x2){cvt_pk_bf16(acc[0], acc[1]), cvt_pk_bf16(acc[2], acc[3])};
            }
        }
    }
}
__device__ __forceinline__ void wuv_wave(const Ctx& F) {
    unsigned char* ws = F.ws; const int lane = F.lane, fr = lane & 15, g = lane >> 4;
    for (int wq = F.gw; wq < 2048; wq += F.NGW) {
        const int h = wq & 15;
        bf16x8 af[4][8];
#pragma unroll
        for (int dt = 0; dt < 4; ++dt)
#pragma unroll
            for (int ks = 0; ks < 8; ++ks) af[dt][ks] = ld_bf16x8((const bf16*)(ws + WS_WUV) + ((size_t)h * 64 + 16 * dt + fr) * 256 + 32 * ks + 8 * g);
        for (int tt = (wq >> 4); tt < 1024; tt += 128) {
            const bf16* ol = (const bf16*)(ws + WS_QOP) + ((size_t)(16 * tt + fr) * 16 + h) * 272 + 8 * g;
            bf16x8 bfv[8];
#pragma unroll
            for (int ks = 0; ks < 8; ++ks) bfv[ks] = ld_bf16x8(ol + 32 * ks);
            bf16* ao = (bf16*)(ws + WS_AOUT) + (size_t)(16 * tt + fr) * 1024 + 64 * h + 4 * g;
#pragma unroll
            for (int dt = 0; dt < 4; ++dt) {
                f32x4 acc = {0.f, 0.f, 0.f, 0.f};
#pragma unroll
                for (int ks = 0; ks < 8; ++ks) acc = __builtin_amdgcn_mfma_f32_16x16x32_bf16(af[dt][ks], bfv[ks], acc, 0, 0, 0);
                *(u32x2*)(ao + 16 * dt) = (u32x2){cvt_pk_bf16(acc[0], acc[1]), cvt_pk_bf16(acc[2], acc[3])};
            }
        }
    }
}

__device__ __forceinline__ unsigned sortkey(float x) { const unsigned u = __builtin_bit_cast(unsigned, x); return (u & 0x80000000u) ? ~u : (u | 0x80000000u); }
#ifndef DBG_NRND
#define DBG_NRND 3
#endif
template <int MODE>
__device__ __forceinline__ void indexer_tile(const Ctx& F, int b, int qt) {
    unsigned char* ws = F.ws; const int lane = F.lane, wave = F.wave, r32 = lane & 31, hf = lane >> 5;
    LAS unsigned* hist = (LAS unsigned*)F.lds;
    LAS unsigned* st = (LAS unsigned*)(F.lds + 133120);
    const int t0 = qt * 8, ntile = ((t0 + 7) >> 5) + 1, nslot = (ntile + 7) >> 3;
    const size_t rowb = (size_t)b * SEQ;
    bf16x8 qa[2][4]; float w[2][2][8];
    { const int hq = (r32 >> 2) & 1, sl = r32 >> 4, hd = (r32 & 3) + 4 * ((r32 >> 3) & 1);
#pragma unroll
      for (int G = 0; G < 2; ++G)
#pragma unroll
          for (int ks = 0; ks < 4; ++ks) qa[G][ks] = ld_bf16x8((const bf16*)(ws + WS_QI) + (rowb + t0 + 4 * G + 2 * hq + sl) * 512 + hd * 64 + 16 * ks + 8 * hf);
#pragma unroll
      for (int G = 0; G < 2; ++G)
#pragma unroll
          for (int s = 0; s < 2; ++s) { const float* wp = (const float*)(ws + WS_WI) + (rowb + t0 + 4 * G + 2 * hf + s) * 8; const f32x4 w0 = *(const f32x4*)wp, w1 = *(const f32x4*)(wp + 4);
#pragma unroll
              for (int e = 0; e < 4; ++e) { w[G][s][e] = w0[e]; w[G][s][4 + e] = w1[e]; } } }
    LAS unsigned char* kring = F.lds + wave * 16384;
    const int ns = (ntile - wave + 7) >> 3;
    const unsigned char* kbase_ = ws + WS_KI + ((rowb + 32 * wave + r32) * 64 + 8 * hf) * 2;
#define IDX_ISSUE(S_) do { _Pragma("unroll") for (int ks_ = 0; ks_ < 4; ++ks_) \
        __builtin_amdgcn_global_load_lds((const unsigned*)(kbase_ + (size_t)(S_) * (256 * 64 * 2) + 32 * ks_), (LAS unsigned*)(kring + ((S_) & 3) * 4096 + ks_ * 1024), 16, 0, 0); } while (0)
    if (0 < ns) IDX_ISSUE(0);
    if (1 < ns) IDX_ISSUE(1);
    if (2 < ns) IDX_ISSUE(2);
    unsigned sc[16][2][2];
#pragma unroll
    for (int G = 0; G < 2; ++G) {
#pragma unroll
        for (int ks = 0; ks < 4; ++ks) asm volatile("" :: "v"(qa[G][ks]));
#pragma unroll
        for (int sl = 0; sl < 2; ++sl)
#pragma unroll
            for (int hd = 0; hd < 8; ++hd) asm volatile("" :: "v"(w[G][sl][hd])); }
#pragma unroll
    for (int s = 0; s < 16; ++s) {
        const int j = wave + 8 * s;
        if (s < ns) {
            if (s + 3 < ns) IDX_ISSUE(s + 3);
            { const int rem = ns - 1 - s;
#ifdef DBG_RINGVM0
              (void)rem; asm volatile("s_waitcnt vmcnt(0)" ::: "memory");
#else
              if (rem >= 3) asm volatile("s_waitcnt vmcnt(12)" ::: "memory"); else if (rem == 2) asm volatile("s_waitcnt vmcnt(8)" ::: "memory");
              else if (rem == 1) asm volatile("s_waitcnt vmcnt(4)" ::: "memory"); else asm volatile("s_waitcnt vmcnt(0)" ::: "memory");
#endif
            }
            bf16x8 kb[4];
#pragma unroll
#ifdef DBG_NORING
            for (int ks = 0; ks < 4; ++ks) kb[ks] = ld_bf16x8((const bf16*)(kbase_ + (size_t)s * (256 * 64 * 2) + 32 * ks));
#else
            for (int ks = 0; ks < 4; ++ks) kb[ks] = *(const LAS bf16x8*)(kring + (s & 3) * 4096 + ks * 1024 + lane * 16);
#endif
            int rr_ = r32; asm volatile("" : "+v"(rr_)); const int key = 32 * j + rr_;
#pragma unroll
            for (int G = 0; G < 2; ++G) {
                f32x16 acc;
#pragma unroll
                for (int e = 0; e < 16; ++e) acc[e] = 0.f;
#pragma unroll
                for (int ks = 0; ks < 4; ++ks) acc = __builtin_amdgcn_mfma_f32_32x32x16_bf16(qa[G][ks], kb[ks], acc, 0, 0, 0);
#pragma unroll
                for (int sl = 0; sl < 2; ++sl) { float v = 0.f;
#pragma unroll
                    for (int hd = 0; hd < 8; ++hd) v += w[G][sl][hd] * fmaxf(acc[8 * sl + hd], 0.f);
                    sc[s][G][sl] = (key <= t0 + 4 * G + 2 * hf + sl) ? (unsigned)__builtin_amdgcn_fmed3f(v * 131072.0f + 1048576.0f, 0.0f, 2097151.0f) : 0xffffffffu; }
            }
            LDS_WAIT();
        } else {
#pragma unroll
            for (int G = 0; G < 2; ++G) { sc[s][G][0] = 0xffffffffu; sc[s][G][1] = 0xffffffffu; }
        }
        asm volatile("" ::: "memory"); SBAR();
    }
#undef IDX_ISSUE
    if (F.tid < 8) { const int t = t0 + F.tid; st[F.tid * 8 + 0] = 0u; st[F.tid * 8 + 1] = 0u; st[F.tid * 8 + 2] = (unsigned)(t + 1 < 256 ? t + 1 : 256); st[F.tid * 8 + 3] = 0u; st[F.tid * 8 + 4] = 1u; st[F.tid * 8 + 5] = 0u; st[F.tid * 8 + 6] = 0u; st[F.tid * 8 + 7] = 0u; }
    __syncthreads();
    if (MODE == 1) { unsigned cs = 0u;
#pragma unroll
        for (int s = 0; s < 16; ++s) cs ^= sc[s][0][0] ^ sc[s][0][1] ^ sc[s][1][0] ^ sc[s][1][1];
        ((unsigned*)(ws + WS_AOUT))[(size_t)(F.gw * 64 + lane)] = cs; return; }
    constexpr int HROW = 2052;
#pragma unroll 1
    for (int rnd = 0; rnd < DBG_NRND; ++rnd) {
#ifndef DBG_NOCAND
        if (rnd == 1) {
            LAS unsigned* clist = hist;
            int kbA = 32 * wave + r32; asm volatile("" : "+v"(kbA));
#pragma unroll
            for (int G = 0; G < 2; ++G)
#pragma unroll
                for (int sl = 0; sl < 2; ++sl) {
                    const int q = 4 * G + 2 * hf + sl;
                    const unsigned T0 = (st[q * 8 + 4] != 0u) ? (st[q * 8 + 0] >> 10) : 0xffffffffu;
#pragma unroll
                    for (int s = 0; s < 16; ++s) if (s < nslot) { unsigned sk = sc[s][G][sl]; asm volatile("" : "+v"(sk));
                        if ((sk >> 10) == T0) { const unsigned pos = __hip_atomic_fetch_add(st + q * 8 + 5, 1u, __ATOMIC_RELAXED, __HIP_MEMORY_SCOPE_WORKGROUP);
                            if (pos < 256u) clist[q * 256 + pos] = ((sk & 1023u) << 12) | (4095u - (unsigned)(kbA + 256 * s)); } }
                }
            __syncthreads();
            { const int q = wave; const unsigned c = st[q * 8 + 5], krem = st[q * 8 + 2], T0 = st[q * 8 + 0] >> 10;
              if (st[q * 8 + 4] != 0u && c <= 256u) {
                  unsigned mine[4], cnt[4];
#pragma unroll
                  for (int k4 = 0; k4 < 4; ++k4) { mine[k4] = (lane + 64 * k4 < (int)c) ? clist[q * 256 + lane + 64 * k4] : 0xffffffffu; cnt[k4] = 0u; }
                  for (unsigned j = 0; j < c; ++j) { const unsigned v = clist[q * 256 + j];
#pragma unroll
                      for (int k4 = 0; k4 < 4; ++k4) cnt[k4] += (v > mine[k4]) ? 1u : 0u; }
#pragma unroll
                  for (int k4 = 0; k4 < 4; ++k4) if (lane + 64 * k4 < (int)c && cnt[k4] == krem - 1u) {
#ifdef DBG_CANDCHK
                      st[q * 8 + 6] = (T0 << 10) | (mine[k4] >> 12); st[q * 8 + 7] = (mine[k4] & 4095u) | 0x80000000u;
#else
                      st[q * 8 + 0] = (T0 << 10) | (mine[k4] >> 12); st[q * 8 + 1] = mine[k4] & 4095u; st[q * 8 + 2] = 0u; st[q * 8 + 4] = 0u;
#endif
                  }
              } }
            __syncthreads();
        }
#endif
        if (rnd > 0) { unsigned unres = 0u;
#pragma unroll
            for (int q8 = 0; q8 < 8; ++q8) unres |= st[q8 * 8 + 4];
            if (unres == 0u) break; }
        for (int i = F.tid; i < 8 * HROW / 4; i += NTHR) ((LAS u32x4*)hist)[i] = (u32x4){0u, 0u, 0u, 0u};
        __syncthreads();
        int kbase = 32 * wave + r32; asm volatile("" : "+v"(kbase));
#pragma unroll
        for (int G = 0; G < 2; ++G)
#pragma unroll
            for (int sl = 0; sl < 2; ++sl) {
                const int q = 4 * G + 2 * hf + sl;
                const unsigned Ts = st[q * 8 + 0], Tl = st[q * 8 + 1];
                LAS unsigned* hq = hist + q * HROW;
                if (rnd == 0) {
#pragma unroll
                    for (int s = 0; s < 16; ++s) if (s < nslot) { unsigned sk = sc[s][G][sl]; asm volatile("" : "+v"(sk));
                        if (sk != 0xffffffffu) __hip_atomic_fetch_add(hq + (sk >> 10), 1u, __ATOMIC_RELAXED, __HIP_MEMORY_SCOPE_WORKGROUP); }
                } else if (rnd == 1) {
                    const unsigned T0 = (st[q * 8 + 4] != 0u) ? (Ts >> 10) : 0xffffffffu;
#pragma unroll
                    for (int s = 0; s < 16; ++s) if (s < nslot) { unsigned sk = sc[s][G][sl]; asm volatile("" : "+v"(sk));
                        if ((sk >> 10) == T0) __hip_atomic_fetch_add(hq + (((sk & 1023u) << 1) | (s < 8 ? 1u : 0u)), 1u, __ATOMIC_RELAXED, __HIP_MEMORY_SCOPE_WORKGROUP); }
                } else {
                    const bool act = st[q * 8 + 4] != 0u;
#pragma unroll
                    for (int s = 0; s < 16; ++s) if (s < nslot) { unsigned sk = sc[s][G][sl]; asm volatile("" : "+v"(sk));
                        const unsigned lo = 4095u - (unsigned)(kbase + 256 * s);
                        if (act && sk == Ts && (lo >> 11) == (Tl >> 11)) __hip_atomic_fetch_add(hq + (lo & 2047u), 1u, __ATOMIC_RELAXED, __HIP_MEMORY_SCOPE_WORKGROUP); }
                }
            }
        __syncthreads();
        { const int q = wave; const unsigned krem = st[q * 8 + 2];
          unsigned hb[32];
#pragma unroll
          for (int i4 = 0; i4 < 8; ++i4) { const u32x4 v = *(const LAS u32x4*)(hist + q * HROW + 32 * lane + 4 * i4); hb[4 * i4] = v.x; hb[4 * i4 + 1] = v.y; hb[4 * i4 + 2] = v.z; hb[4 * i4 + 3] = v.w; }
          unsigned tot = 0u;
#pragma unroll
          for (int i = 0; i < 32; ++i) tot += hb[i];
          unsigned incl = tot;
#pragma unroll
          for (int o = 1; o < 64; o <<= 1) { const unsigned tv = __shfl_down(incl, o); if (lane + o < 64) incl += tv; }
          const unsigned excl = incl - tot;
          if ((rnd == 0 || st[q * 8 + 4] != 0u) && excl < krem && krem <= incl) {
              unsigned c = excl, above = excl, hb_sel = 0u; int bsel = 0; bool found = false;
#pragma unroll
              for (int i = 31; i >= 0; --i) { if (!found) { if (c + hb[i] >= krem) { found = true; bsel = i; above = c; hb_sel = hb[i]; } c += hb[i]; } }
              const unsigned bin = (unsigned)(32 * lane + bsel);
              unsigned Ts = st[q * 8 + 0], Tl = st[q * 8 + 1];
              if (rnd == 0) Ts = bin << 10;
              else if (rnd == 1) { Ts |= bin >> 1; Tl = (bin & 1u) << 11; }
              else Tl |= bin;
              st[q * 8 + 0] = Ts; st[q * 8 + 1] = Tl; st[q * 8 + 2] = krem - above;
              st[q * 8 + 4] = (krem - above == hb_sel) ? 0u : 1u;
          } }
        __syncthreads();
    }
#ifdef DBG_CANDCHK
    if (F.tid < 8 && (st[F.tid * 8 + 7] & 0x80000000u) != 0u) {
        atomicAdd((unsigned*)(ws + WS_CTL) + 3000, 1u);
        const unsigned tr = st[F.tid * 8 + 7] & 4095u, th = st[F.tid * 8 + 1];
        const bool same = st[F.tid * 8 + 6] == st[F.tid * 8 + 0] && (tr == th || ((th & 2047u) == 0u && (tr >> 11) == (th >> 11)));
        if (!same) atomicAdd((unsigned*)(ws + WS_CTL) + 3001, 1u); }
#endif
    if (MODE == 2) { if (F.tid < 64) ((unsigned*)(ws + WS_AOUT))[(size_t)(F.vcu * 64 + F.tid)] = st[F.tid]; __syncthreads(); return; }
#ifdef DBG_TS
    if (F.tid < 8) { int* dbg = (int*)(ws + WS_AOUT) + (rowb + t0 + F.tid) * 4; dbg[0] = (int)st[F.tid * 8 + 0]; dbg[1] = (int)st[F.tid * 8 + 1]; dbg[2] = (int)st[F.tid * 8 + 2]; dbg[3] = (int)st[F.tid * 8 + 4]; }
#endif
    LAS int* keyL = (LAS int*)(F.lds + 135168);
    LAS unsigned* wtot = (LAS unsigned*)(F.lds + 133120 + 1024);
#define IDX_SEL(SK, KEY, TS, TL) ((SK) != 0xffffffffu && ((SK) > (TS) || ((SK) == (TS) && (4095u - (unsigned)(KEY)) >= (TL))))
    unsigned lpre[2][2];
#pragma unroll
    for (int G = 0; G < 2; ++G)
#pragma unroll
        for (int sl = 0; sl < 2; ++sl) {
            const int q = 4 * G + 2 * hf + sl;
            const unsigned Ts = st[q * 8 + 0], Tl = st[q * 8 + 1];
            int kbA = 32 * wave + r32; asm volatile("" : "+v"(kbA));
            unsigned c = 0u;
#pragma unroll
            for (int s = 0; s < 16; ++s) if (s < nslot) c += IDX_SEL(sc[s][G][sl], kbA + 256 * s, Ts, Tl) ? 1u : 0u;
            unsigned incl = c;
#pragma unroll
            for (int o = 1; o < 32; o <<= 1) { const unsigned tv = __shfl_up(incl, o); if (r32 >= o) incl += tv; }
            lpre[G][sl] = incl - c;
            if (r32 == 31) wtot[q * 8 + wave] = incl;
        }
    __syncthreads();
#pragma unroll
    for (int G = 0; G < 2; ++G)
#pragma unroll
        for (int sl = 0; sl < 2; ++sl) {
            const int q = 4 * G + 2 * hf + sl;
            const unsigned Ts = st[q * 8 + 0], Tl = st[q * 8 + 1];
            unsigned pos = lpre[G][sl];
#pragma unroll
            for (int w8 = 0; w8 < 7; ++w8) pos += (w8 < wave) ? wtot[q * 8 + w8] : 0u;
            LAS int* out = keyL + q * 256;
            int kbC = 32 * wave + r32; asm volatile("" : "+v"(kbC));
#pragma unroll
            for (int s = 0; s < 16; ++s) if (s < nslot) {
                unsigned skv = sc[s][G][sl]; asm volatile("" : "+v"(skv));
                const int key = kbC + 256 * s;
                if (IDX_SEL(skv, key, Ts, Tl)) { if (pos < 256u) out[pos] = key; ++pos; }
            }
        }
#undef IDX_SEL
    __syncthreads();
    { const int q = wave;
      *(u32x4*)((int*)(ws + WS_IDX) + (rowb + t0 + q) * 256 + 4 * lane) = *(const LAS u32x4*)(keyL + q * 256 + 4 * lane); }
    __syncthreads();
}

typedef short bf16x4 __attribute__((ext_vector_type(4)));
constexpr int SP_BUF = 8960, SP_WAVE = 1024 + 2 * SP_BUF;
__device__ __forceinline__ void sparse_issue(const unsigned char* KOb, const LAS unsigned* idxL, LAS unsigned char* buf, int c, int lane) {
#pragma unroll
    for (int i = 0; i < 8; ++i) { const unsigned ro = idxL[16 * c + i + 8 * (lane >> 5)];
        __builtin_amdgcn_global_load_lds((const unsigned*)(KOb + ro + 16 * (lane & 31)), (LAS unsigned*)(buf + i * 1056), 16, 0, 0); }
    if (lane < 32) { const unsigned ro = idxL[16 * c + (lane >> 1)];
        __builtin_amdgcn_global_load_lds((const unsigned*)(KOb + ro + 512 + 16 * (lane & 1)), (LAS unsigned*)(buf + 8448), 16, 0, 0); }
}
__device__ __forceinline__ void sparse_query(const Ctx& F, int row, LAS unsigned char* wl  , bf16* dummy_out = nullptr) {
    unsigned char* ws = F.ws; const int lane = F.lane, fr = lane & 15, g = lane >> 4;
    const int t = row & (SEQ - 1); const size_t rowb = (size_t)(row - t);
    const int nval = t + 1 < 256 ? t + 1 : 256, nch = (nval + 15) >> 4;
    bf16* qp = (bf16*)(ws + WS_QOP) + ((size_t)row * 16 + fr) * 272;
    LAS unsigned* idxL = (LAS unsigned*)wl;
    LAS unsigned char* buf0 = wl + 1024;
    const unsigned char* KOb = ws + WS_KOP + rowb * 544;
    { const u32x4 iv = *(const u32x4*)((const int*)(ws + WS_IDX) + (size_t)row * 256 + 4 * lane);
      u32x4 ov;
#pragma unroll
      for (int e = 0; e < 4; ++e) ov[e] = (4 * lane + e < nval) ? (iv[e] & (SEQ - 1)) * 544u : 0u;
      *(LAS u32x4*)(idxL + 4 * lane) = ov; }
    bf16x8 qf[9];
#pragma unroll
    for (int ks = 0; ks < 8; ++ks) qf[ks] = ld_bf16x8(qp + 32 * ks + 8 * g);
    qf[8] = (bf16x8){0, 0, 0, 0, 0, 0, 0, 0};
    if (g < 2) qf[8] = ld_bf16x8(qp + 256 + 8 * g);
#pragma unroll
    for (int ks = 0; ks < 9; ++ks) asm volatile("" :: "v"(qf[ks]));
    LDS_WAIT(); asm volatile("" ::: "memory");
    sparse_issue(KOb, idxL, buf0, 0, lane);
    if (nch > 1) sparse_issue(KOb, idxL, buf0 + SP_BUF, 1, lane);
    float mrun = -1.0e30f, lsum = 0.f;
    f32x4 o[16];
#pragma unroll
    for (int ct = 0; ct < 16; ++ct) o[ct] = (f32x4){0.f, 0.f, 0.f, 0.f};
    const unsigned arow = (unsigned)((fr & 7) * 1056 + (fr >> 3) * 512 + 16 * g);
    const unsigned trow = (unsigned)(((4 * g + (fr >> 2)) & 7) * 1056 + ((4 * g + (fr >> 2)) >> 3) * 512 + (fr & 3) * 8);
#pragma unroll 1
    for (int c = 0; c < nch; ++c) {
        LAS unsigned char* buf = buf0 + (c & 1) * SP_BUF;
        if (c + 1 < nch) asm volatile("s_waitcnt vmcnt(9)" ::: "memory"); else asm volatile("s_waitcnt vmcnt(0)" ::: "memory");
        f32x4 sa = {0.f, 0.f, 0.f, 0.f};
#pragma unroll
        for (int ks = 0; ks < 8; ++ks) { const bf16x8 a = *(const LAS bf16x8*)(buf + arow + 64 * ks);
            sa = __builtin_amdgcn_mfma_f32_16x16x32_bf16(a, qf[ks], sa, 0, 0, 0); }
        { bf16x8 a = {0, 0, 0, 0, 0, 0, 0, 0};
          if (g < 2) a = *(const LAS bf16x8*)(buf + 8448 + fr * 32 + 16 * g);
          sa = __builtin_amdgcn_mfma_f32_16x16x32_bf16(a, qf[8], sa, 0, 0, 0); }
        float cmax = -INFINITY;
#pragma unroll
        for (int e = 0; e < 4; ++e) { sa[e] = (16 * c + 4 * g + e < nval) ? sa[e] : -INFINITY; cmax = fmaxf(cmax, sa[e]); }
        cmax = fmaxf(cmax, __shfl_xor(cmax, 16)); cmax = fmaxf(cmax, __shfl_xor(cmax, 32));
        if (__any(cmax > mrun + 64.0f)) {
            const float mnew = fmaxf(mrun, cmax), alpha = __builtin_amdgcn_exp2f((mrun - mnew) * 0.18033688011f);
            mrun = mnew; lsum *= alpha;
#pragma unroll
            for (int ct = 0; ct < 16; ++ct) o[ct] *= alpha;
        }
        const float mneg = -mrun * 0.18033688011f;
        float ps = 0.f;
#pragma unroll
        for (int e = 0; e < 4; ++e) { sa[e] = __builtin_amdgcn_exp2f(__builtin_fmaf(sa[e], 0.18033688011f, mneg)); ps += sa[e]; }
        lsum += ps;
        bf16x4 pf;
        { const u32x2 pk = {cvt_pk_bf16(sa[0], sa[1]), cvt_pk_bf16(sa[2], sa[3])}; pf = __builtin_bit_cast(bf16x4, pk); }
        const unsigned vaddr = (unsigned)(uintptr_t)buf + trow;
#pragma unroll
        for (int c4 = 0; c4 < 2; ++c4) {
            s16x4 vt[8];
#pragma unroll
            for (int d = 0; d < 8; ++d) TRRD(vt[d], vaddr, (c4 * 8 + d) * 32);
            asm volatile("s_waitcnt lgkmcnt(0)" ::: "memory"); SBAR();
#pragma unroll
            for (int d = 0; d < 8; ++d) o[c4 * 8 + d] = __builtin_amdgcn_mfma_f32_16x16x16bf16_1k(vt[d], pf, o[c4 * 8 + d], 0, 0, 0);
        }
        if (c + 2 < nch) sparse_issue(KOb, idxL, buf, c + 2, lane);
    }
    lsum += __shfl_xor(lsum, 16); lsum += __shfl_xor(lsum, 32);
    const float inv = 1.0f / lsum;
    bf16* op = dummy_out ? dummy_out + fr * 272 : qp;
#pragma unroll
    for (int ct = 0; ct < 16; ++ct) *(u32x2*)(op + 16 * ct + 4 * g) = (u32x2){cvt_pk_bf16(o[ct][0] * inv, o[ct][1] * inv), cvt_pk_bf16(o[ct][2] * inv, o[ct][3] * inv)};
    LDS_WAIT(); asm volatile("" ::: "memory");
}

constexpr int NPHASE = 21;
#ifndef MK_PER_PHASE
#define MK_PER_PHASE 0
#endif

__device__ __forceinline__ void moe_table(const Ctx& F) {
    LAS int* tab = (LAS int*)(F.lds + MISC_OFF + 64);
    if (F.tid == 0) { int accu = 0;
        for (int e = 0; e < 8; ++e) { const int c = (int)__hip_atomic_load((unsigned*)(F.ws + WS_CTL) + CW_CNT + e, RLX_AGENT); tab[e] = c; tab[8 + e] = accu; accu += (c + 255) >> 8; }
        tab[16] = accu; }
    __syncthreads();
}

__global__ void __launch_bounds__(NTHR, 2) mk_fwd(Args args) {
    extern __shared__ __attribute__((aligned(16))) unsigned char lds_raw[];
    Ctx F;
    F.lds = (LAS unsigned char*)lds_raw;
    F.tid = threadIdx.x; F.lane = F.tid & 63; F.wave = __builtin_amdgcn_readfirstlane(F.tid >> 6);
    F.G = gridDim.x; { const int bx = blockIdx.x; F.vcu = (F.G % 8 == 0) ? (bx % 8) * (F.G / 8) + bx / 8 : bx; }
    F.gw = F.vcu * NWAVES + F.wave; F.NGW = F.G * NWAVES;
    F.ws = args.ws;
    unsigned char* ws = args.ws;
    volatile LAS unsigned* MISC = (volatile LAS unsigned*)(F.lds + MISC_OFF);
    if (F.tid < 64) MISC[F.tid] = 0u;
    __syncthreads();
    XcdBarrier bar; bar.bar = (unsigned*)(ws + WS_CTL) + CW_BAR; bar.x = 0; bar.st = nullptr; bar.wave = F.wave;
#if !MK_PER_PHASE
    bar = xcd_barrier_post((unsigned*)(ws + WS_CTL) + CW_BAR, MISC + 8, F.wave);
#define GRID_BAR() xcd_barrier(bar)
#else
#define GRID_BAR() do {} while (0)
#endif
    const int lo = args.ph_lo, hi = args.ph_hi;
#ifndef PH_MASK
#define PH_MASK 0xFFFFFFFFu
#endif
#define IN(k) ((((PH_MASK) >> (k)) & 1u) && lo <= (k) && (k) < hi)
#define FRESH() Ctx P = F; P.lane = (int)__builtin_amdgcn_mbcnt_hi(~0u, __builtin_amdgcn_mbcnt_lo(~0u, 0u)); asm volatile("" : "+v"(P.lane)); P.tid = P.wave * 64 + P.lane
#ifndef DBG_REPMASK
#define DBG_REPMASK 0u
#endif
#define REPN(k) ((((DBG_REPMASK) >> (k)) & 1u) ? 2 : 1)
#define SEAM(k) do { if (IN(k) && IN((k) + 1)) GRID_BAR(); } while (0)
    const float* MODF = (const float*)(ws + WS_MODF);
    const float* ROPE = (const float*)(ws + WS_ROPE);

    if (IN(0)) for (int rep_ = 0; rep_ < REPN(0); ++rep_) { FRESH(); p0_prologue(P, args); } SEAM(0);
    if (IN(1)) for (int rep_ = 0; rep_ < REPN(1); ++rep_) { FRESH(); for (int rb = P.gw; rb < 2048; rb += P.NGW) { Ctx Fr = P; Fr.gw = rb; norm_phase<true, false, false, false>(Fr, args, args.in[I_X], args.in[I_GMIX], 0, 0, 1024); } modf_finalize(P, args); } SEAM(1);
    if (IN(2)) for (int rep_ = 0; rep_ < REPN(2); ++rep_) { FRESH();
        pg8::Gemm g{(const bf16*)(ws + WS_U), (const bf16*)(ws + WS_WIN0), 1024}; pg8::StaticOrder S; S.init(T, 2048, 1024, P.G, (int)blockIdx.x);
        EpiProj E{(bf16*)(ws + WS_PROJ), 2048, ROPE, 4};
        pg8::gemm_phase(P.lds, g, S, E, P.wave);
    } SEAM(2);
    if (IN(3)) for (int rep_ = 0; rep_ < REPN(3); ++rep_) { FRESH();
        for (int u = P.gw; u < 1920; u += P.NGW) s5_unit<false>(P, args, u / 480, (u / 15) % 32, u % 15, P.lds + P.wave * S5_LDS);
        for (int u = P.gw; u < 8192; u += P.NGW) dil_unit(P, u >> 11, (u >> 8) & 7, (u >> 4) & 15, u & 15, P.lds + P.wave * S5_LDS);
    } SEAM(3);
    if (IN(4)) for (int rep_ = 0; rep_ < REPN(4); ++rep_) { FRESH(); for (int u = P.gw; u < 2048; u += P.NGW) s5_unit<true>(P, args, u >> 9, (u >> 4) & 31, u & 15, P.lds + P.wave * S5_LDS); } SEAM(4);
    if (IN(5)) for (int rep_ = 0; rep_ < REPN(5); ++rep_) { FRESH();
        pg8::Gemm g{(const bf16*)(ws + WS_YG), (const bf16*)(ws + WS_WGLU), 512}; pg8::StaticOrder S; S.init(T, 512, 512, P.G, (int)blockIdx.x);
        EpiGlu E{(bf16*)(ws + WS_CAT), 1024, 512, (const bf16*)(ws + WS_YG), 512, args.in[I_BGLU]};
        pg8::gemm_phase(P.lds, g, S, E, P.wave);
    } SEAM(5);
    if (IN(6)) for (int rep_ = 0; rep_ < REPN(6); ++rep_) { FRESH();
        pg8::Gemm g{(const bf16*)(ws + WS_CAT), (const bf16*)(ws + WS_WOUT0), 1024}; pg8::StaticOrder S; S.init(T, 1024, 1024, P.G, (int)blockIdx.x);
        EpiResid E{args.in[I_X], (bf16*)(ws + WS_H), MODF + 2048};
        pg8::gemm_phase(P.lds, g, S, E, P.wave);
    } SEAM(6);
    if (IN(7)) for (int rep_ = 0; rep_ < REPN(7); ++rep_) { FRESH(); for (int rb = P.gw; rb < 2048; rb += P.NGW) { Ctx Fr = P; Fr.gw = rb; norm_phase<false, false, true>(Fr, args, ws + WS_H, args.in[I_GFFN], 0, 3072, 4096); } } SEAM(7);
    if (IN(8)) for (int rep_ = 0; rep_ < REPN(8); ++rep_) { FRESH();
        pg8::Gemm g{(const bf16*)(ws + WS_U8), (const bf16*)(ws + WS_WGU0), 512}; pg8::StaticOrder S; S.init(T, 2 * FFD, 512, P.G, (int)blockIdx.x);
        EpiSwiglu8 E{ws + WS_ACT0, FFD};
        pg8::gemm_phase<EpiSwiglu8, pg8::StaticOrder, true>(P.lds, g, S, E, P.wave);
    } SEAM(8);
    if (IN(9)) for (int rep_ = 0; rep_ < REPN(9); ++rep_) { FRESH();
        pg8::Gemm g{(const bf16*)(ws + WS_ACT0), (const bf16*)(ws + WS_WDN0), FFD / 2}; pg8::StaticOrder S; S.init(T, 1024, FFD / 2, P.G, (int)blockIdx.x);
        EpiResidH E{(const bf16*)(ws + WS_H), (REPN(9) == 2 && rep_ == 0) ? (bf16*)(ws + 360 * MiB) : (bf16*)(ws + WS_H), MODF + 5120, 0.03125f};
        pg8::gemm_phase<EpiResidH, pg8::StaticOrder, true, true>(P.lds, g, S, E, P.wave);
    } SEAM(9);
    if (IN(10)) for (int rep_ = 0; rep_ < REPN(10); ++rep_) { FRESH(); for (int rb = P.gw; rb < 2048; rb += P.NGW) { Ctx Fr = P; Fr.gw = rb; norm_phase<false, false>(Fr, args, ws + WS_H, args.in[I_GMIX] + 1024, 1, 0, 1024); } } SEAM(10);
    if (IN(11)) for (int rep_ = 0; rep_ < REPN(11); ++rep_) { FRESH();
        pg8::Gemm g{(const bf16*)(ws + WS_U), (const bf16*)(ws + WS_WIN1), 1024}; pg8::StaticOrder S; S.init(T, 2048, 1024, P.G, (int)blockIdx.x);
        EpiProj E{(bf16*)(ws + WS_PROJ), 2048, ROPE, 0};
        pg8::gemm_phase(P.lds, g, S, E, P.wave);
    } SEAM(11);
    if (IN(12)) for (int rep_ = 0; rep_ < REPN(12); ++rep_) { FRESH(); for (int row = P.gw; row < T; row += P.NGW) prep1_token(P, args, row); qlat_wave(P); } SEAM(12);
    if (IN(13)) for (int rep_ = 0; rep_ < REPN(13); ++rep_) { FRESH(); for (int vw = P.vcu; vw < 256; vw += P.G) for (int i = 0; i < 8; ++i) indexer_tile<0>(P, i >> 1, (i & 1) ? 511 - vw : vw);
#ifdef DBG_IDXMODE
        { Ctx Q2 = P; asm volatile("" : "+v"(Q2.lane)); Q2.tid = Q2.wave * 64 + Q2.lane;
          for (int vw = Q2.vcu; vw < 256; vw += Q2.G) for (int i = 0; i < 8; ++i) indexer_tile<DBG_IDXMODE>(Q2, i >> 1, (i & 1) ? 511 - vw : vw); }
#endif
        } SEAM(13);
    if (IN(14)) for (int rep_ = 0; rep_ < REPN(14); ++rep_) { FRESH(); for (int u = P.gw; u < T; u += P.NGW) { const int b = (u & 2047) >> 9, wib = u & 511, i = u >> 11; sparse_query(P, b * SEQ + wib + 512 * i, P.lds + P.wave * SP_WAVE, (REPN(14) == 2 && rep_ == 0) ? (bf16*)(ws + WS_AOUT) + (size_t)P.gw * 4352 : nullptr); } } SEAM(14);
    if (IN(15)) for (int rep_ = 0; rep_ < REPN(15); ++rep_) { FRESH(); wuv_wave(P); } SEAM(15);
    if (IN(16)) for (int rep_ = 0; rep_ < REPN(16); ++rep_) { FRESH();
        pg8::Gemm g{(const bf16*)(ws + WS_AOUT), (const bf16*)(ws + WS_WOUT1), 1024}; pg8::StaticOrder S; S.init(T, 1024, 1024, P.G, (int)blockIdx.x);
        EpiResidH E{(const bf16*)(ws + WS_H), (REPN(16) == 2 && rep_ == 0) ? (bf16*)(ws + WS_QOP) : (bf16*)(ws + WS_H), MODF + 4 * 6144 + 2048, 1.0f};
        pg8::gemm_phase(P.lds, g, S, E, P.wave);
    } SEAM(16);
    if (IN(17)) for (int rep_ = 0; rep_ < REPN(17); ++rep_) { FRESH(); for (int rb = P.gw; rb < 2048; rb += P.NGW) { Ctx Fr = P; Fr.gw = rb; norm_phase<false, true>(Fr, args, ws + WS_H, args.in[I_GFFN] + 1024, 1, 3072, 4096); } } SEAM(17);
    if (IN(18)) for (int rep_ = 0; rep_ < REPN(18); ++rep_) { FRESH();
        moe_table(P);
        pg8::Gemm g{(const bf16*)(ws + WS_U8), (const bf16*)(ws + WS_WMGU), 512};
#ifdef DBG_NOGATHER
        MoeSched<false> S{(const LAS int*)(P.lds + MISC_OFF + 64), (const int*)(ws + WS_LIST), 28, P.G, (int)blockIdx.x, 8};
#else
        MoeSched<true> S{(const LAS int*)(P.lds + MISC_OFF + 64), (const int*)(ws + WS_LIST), 28, P.G, (int)blockIdx.x, 8};
#endif
        EpiSwiglu8 E{ws + WS_MACT, FFE};
        pg8::gemm_phase<EpiSwiglu8, decltype(S), true>(P.lds, g, S, E, P.wave);
    } SEAM(18);
    if (IN(19)) for (int rep_ = 0; rep_ < REPN(19); ++rep_) { FRESH();
        moe_table(P);
        pg8::Gemm g{(const bf16*)(ws + WS_MACT), (const bf16*)(ws + WS_WMDN), FFE / 2};
        MoeDownSched S{(const LAS int*)(P.lds + MISC_OFF + 64), P.G, (int)blockIdx.x};
        EpiMoeDown E{(bf16*)(ws + WS_YSLOT), (float*)(ws + WS_PART), (const LAS int*)(P.lds + MISC_OFF + 64), (const int*)(ws + WS_LIST), (const float*)(ws + WS_LGATE)};
        pg8::gemm_phase<EpiMoeDown, MoeDownSched, true>(P.lds, g, S, E, P.wave);
    } SEAM(19);
#ifdef DBG_XBAR
    for (int xb_ = 0; xb_ < DBG_XBAR; ++xb_) GRID_BAR();
#endif
    if (IN(20)) for (int rep_ = 0; rep_ < REPN(20); ++rep_) { FRESH(); moe_table(P); for (int rb = P.gw; rb < 2048; rb += P.NGW) { Ctx Fr = P; Fr.gw = rb; final_phase(Fr, args); } }
#if defined(DBG_HASH)
    if (lo == 98) { FRESH();
        const unsigned* src = (const unsigned*)(ws + DBG_HASH); unsigned h = 0u;
        for (size_t i = (size_t)P.vcu * NTHR + P.tid; i < (size_t)(DBG_HASH_BYTES) / 4; i += (size_t)P.G * NTHR) h += src[i] * (unsigned)(2654435761u + 2u * (unsigned)(i & 1023));
        atomicAdd((unsigned*)(ws + WS_CTL) + 2048, h); }
    if (lo == 99) { FRESH(); const unsigned h = __hip_atomic_load((unsigned*)(ws + WS_CTL) + 2048, RLX_AGENT);
        for (size_t i = (size_t)P.vcu * NTHR + P.tid; i < (size_t)T * 1024; i += (size_t)P.G * NTHR) args.out[i] = (float)((h >> (i & 15)) & 0xFFu); }
#elif defined(DBG_MACT)
    if (lo == 99) { FRESH(); moe_table(P); const LAS int* tab = (const LAS int*)(P.lds + MISC_OFF + 64);
        for (size_t i = (size_t)P.vcu * NTHR + P.tid; i < (size_t)T * 1024; i += (size_t)P.G * NTHR) { const size_t row = i >> 10; const int c = (int)(i & 1023); float s = 0.f;
            const int ep = ((const int*)(ws + WS_KI))[row * 2 + DBG_MACT - 1]; const int e = ep >> 14, pos = ep & 16383; const size_t srow = (size_t)tab[8 + e] * 256 + pos;
            for (int k = c; k < 3584; k += 1024) s += bf2f(((const bf16*)(ws + WS_MACT))[srow * 3584 + k]);
            args.out[i] = s; }
    }
#elif defined(DBG_DUMP)
    if (lo == 99) {
        const bf16* src = (const bf16*)(ws + DBG_DUMP);
        FRESH();
        for (size_t i = (size_t)P.vcu * NTHR + P.tid; i < (size_t)T * 1024; i += (size_t)P.G * NTHR) { const size_t row = i >> 10; const int c = (int)(i & 1023); float s = 0.f;
#if defined(DBG_I32)
#ifdef DBG_ROWSUM
            if ((row & 4095) >= 256 && c == 0) for (int k = 0; k < DBG_NC; ++k) s += (float)((const int*)src)[row * DBG_LD + k];
#else
            if ((row & 4095) >= 256) for (int k = c; k < DBG_NC; k += 1024) s += (float)((const int*)src)[row * DBG_LD + k];
#endif
#elif defined(DBG_F32)
            for (int k = c; k < DBG_NC; k += 1024) s += ((const float*)src)[row * DBG_LD + k];
#else
            for (int k = c; k < DBG_NC; k += 1024) s += bf2f(src[row * DBG_LD + k]);
#endif
            args.out[i] = s; }
    }
#endif
#undef IN
#undef SEAM
}

extern "C" void kernel_launch(void* const* d_in, const int* in_sizes, int n_in, void* d_out, int out_size, void* d_ws, size_t ws_size, hipStream_t stream) {
    static int grid = 0;
    if (grid == 0) {
        if (n_in != 32 || in_sizes[0] != T * D || out_size != T * D || ws_size < WS_END) { fprintf(stderr, "kernel_launch: unexpected shapes / workspace (n_in %d, ws %zu < %zu)\n", n_in, ws_size, (size_t)WS_END); grid = -1; return; }
        int dev = 0, cus = 0, per_cu = 0;
        if (hipGetDevice(&dev) != hipSuccess || hipDeviceGetAttribute(&cus, hipDeviceAttributeMultiprocessorCount, dev) != hipSuccess) { grid = -1; return; }
        if (hipFuncSetAttribute((const void*)mk_fwd, hipFuncAttributeMaxDynamicSharedMemorySize, LDS_BYTES) != hipSuccess) { fprintf(stderr, "kernel_launch: hipFuncSetAttribute failed\n"); grid = -1; return; }
        if (hipOccupancyMaxActiveBlocksPerMultiprocessor(&per_cu, (const void*)mk_fwd, NTHR, LDS_BYTES) != hipSuccess || per_cu < 1) { fprintf(stderr, "kernel_launch: occupancy query says %d\n", per_cu); }
        (void)hipGetLastError();
        grid = cus;
    }
    if (grid < 0) return;
    if (hipMemsetAsync((char*)d_ws + WS_CTL, 0, CTL_ZERO_BYTES, stream) != hipSuccess) return;
    Args a{};
    for (int i = 0; i < 32; ++i) a.in[i] = (const float*)d_in[i];
    a.out = (float*)d_out; a.ws = (unsigned char*)d_ws;
#if MK_PER_PHASE
#ifndef DBG_NPH
#define DBG_NPH NPHASE
#endif
    for (int p = 0; p < DBG_NPH; ++p) { a.ph_lo = p; a.ph_hi = p + 1; hipLaunchKernelGGL(mk_fwd, dim3(grid), dim3(NTHR), LDS_BYTES, stream, a); }
#if defined(DBG_DUMP) || defined(DBG_MACT)
    a.ph_lo = 99; a.ph_hi = 100; hipLaunchKernelGGL(mk_fwd, dim3(grid), dim3(NTHR), LDS_BYTES, stream, a);
#endif
#else
#ifdef DBG_NPH
    a.ph_lo = 0; a.ph_hi = DBG_NPH; hipLaunchKernelGGL(mk_fwd, dim3(grid), dim3(NTHR), LDS_BYTES, stream, a);
#else
    a.ph_lo = 0; a.ph_hi = NPHASE; hipLaunchKernelGGL(mk_fwd, dim3(grid), dim3(NTHR), LDS_BYTES, stream, a);
#endif
#if defined(DBG_HASH)
    a.ph_lo = 98; a.ph_hi = 99; hipLaunchKernelGGL(mk_fwd, dim3(grid), dim3(NTHR), LDS_BYTES, stream, a);
#endif
#if defined(DBG_DUMP) || defined(DBG_MACT) || defined(DBG_HASH)
    a.ph_lo = 99; a.ph_hi = 100; hipLaunchKernelGGL(mk_fwd, dim3(grid), dim3(NTHR), LDS_BYTES, stream, a);
#endif
#endif
}
```
